# Optimizing an MI355X kernel written in HIP

```python
import numpy as np
import jax, jax.numpy as jnp
from jax import lax

D_MODEL = 1024
BATCH = 8
SEQ = 8192
DEPTH = 1
DEC_BATCH = 16
DEC_SEQ = 64
PAST_LEN = 4096

CHUNK = 64
GDN_HEADS = 8
GDN_DK = 128
GDN_DV = 128
GDN_CONV = 4
GDN_QKV = 2 * GDN_HEADS * GDN_DK + GDN_HEADS * GDN_DV
SC_WIDTH = D_MODEL
SC_CONV = 3
N_MEM = 256
XA_HEADS = 4
XA_DIM = D_MODEL // XA_HEADS
D_FF = 2816
EPS = 1e-6
MIX_SPLIT = (GDN_HEADS * GDN_DK, GDN_HEADS * GDN_DK, GDN_HEADS * GDN_DV, GDN_HEADS * GDN_DV,
             GDN_HEADS, GDN_HEADS, SC_WIDTH, SC_WIDTH, SC_WIDTH, D_MODEL, D_MODEL)
MIX_IN = 4 * GDN_HEADS * GDN_DK + 2 * GDN_HEADS + 3 * SC_WIDTH + 2 * D_MODEL

kernel_name = 'hybrid_gdn_shortconv_streaming_encoder'


def rmsnorm(x, g):
    xf = x.astype(jnp.float32)
    y = xf * lax.rsqrt(jnp.mean(xf * xf, axis=-1, keepdims=True) + EPS)
    return (y * g.astype(jnp.float32)).astype(x.dtype)


def l2norm(x):
    return x * lax.rsqrt(jnp.sum(x * x, axis=-1, keepdims=True) + EPS)


def swiglu(x, w_in, w_out):
    gate, up = jnp.split(x @ w_in, 2, axis=-1)
    return (jax.nn.silu(gate) * up) @ w_out


def causal_dwconv(x, buf, w):
    width = w.shape[0]
    t = x.shape[1]
    xp = jnp.concatenate([buf.astype(x.dtype), x], axis=1)
    y = sum(w[i] * xp[:, i:i + t] for i in range(width))
    return y, xp[:, t:]


def gdn_chunk(S, xs):
    q, k, v, g, beta = xs
    L = q.shape[1]
    q, k, v = (jnp.moveaxis(a, 1, 2) for a in (q, k, v))
    gc = jnp.cumsum(jnp.moveaxis(g, 1, 2), axis=-1)
    beta = jnp.moveaxis(beta, 1, 2)
    pos = jnp.arange(L)
    causal = pos[:, None] >= pos[None, :]
    decay = jnp.exp(jnp.where(causal, gc[..., :, None] - gc[..., None, :], -jnp.inf))
    kb = k * beta[..., None]
    a_mat = jnp.where(pos[:, None] > pos[None, :], jnp.einsum('bhlk,bhmk->bhlm', kb, k) * decay, 0.0)
    rhs = jnp.concatenate([v * beta[..., None], kb * jnp.exp(gc)[..., None]], axis=-1)
    sol = lax.linalg.triangular_solve(jnp.eye(L, dtype=a_mat.dtype) + a_mat, rhs,
                                      left_side=True, lower=True)
    u = sol[..., :GDN_DV] - jnp.einsum('bhlk,bhkv->bhlv', sol[..., GDN_DV:], S)
    qk = jnp.einsum('bhlk,bhmk->bhlm', q, k) * decay
    o = (jnp.einsum('bhlk,bhkv->bhlv', q * jnp.exp(gc)[..., None], S)
         + jnp.einsum('bhlm,bhmv->bhlv', qk, u))
    g_end = gc[..., -1:]
    S_new = (S * jnp.exp(g_end)[..., None]
             + jnp.einsum('bhlk,bhlv->bhkv', k * jnp.exp(g_end - gc)[..., None], u))
    return S_new, jnp.moveaxis(o, 2, 1)


def gdn_recurrence(S, q, k, v, g, beta):
    b, t = q.shape[0], q.shape[1]
    L = min(CHUNK, t)
    nc = t // L

    def to_chunks(a):
        return jnp.moveaxis(a.reshape((b, nc, L) + a.shape[2:]), 1, 0)

    S_new, o = lax.scan(gdn_chunk, S, tuple(to_chunks(a) for a in (q, k, v, g, beta)))
    return jnp.moveaxis(o, 0, 1).reshape(b, t, GDN_HEADS, GDN_DV), S_new


def token_mixer(h, S, gbuf, sbuf, p):
    b, t, _ = h.shape
    cuts = [int(c) for c in np.cumsum(MIX_SPLIT)[:-1]]
    q, k, v, z, a, bb, sB, sC, sx, gA, gB = jnp.split(h @ p['w_mix_in'], cuts, axis=-1)
    qkv, gbuf_new = causal_dwconv(jnp.concatenate([q, k, v], axis=-1), gbuf, p['w_gdn_conv'])
    qkv = jax.nn.silu(qkv).astype(jnp.float32)
    q, k, v = jnp.split(qkv, [GDN_HEADS * GDN_DK, 2 * GDN_HEADS * GDN_DK], axis=-1)
    q = l2norm(q.reshape(b, t, GDN_HEADS, GDN_DK)) * (GDN_DK ** -0.5)
    k = l2norm(k.reshape(b, t, GDN_HEADS, GDN_DK))
    v = v.reshape(b, t, GDN_HEADS, GDN_DV)
    g = -jnp.exp(p['gdn_a_log'].astype(jnp.float32)) * jax.nn.softplus(
        a.astype(jnp.float32) + p['gdn_dt_bias'].astype(jnp.float32))
    beta = jax.nn.sigmoid(bb.astype(jnp.float32))
    o, S_new = gdn_recurrence(S.astype(jnp.float32), q, k, v, g, beta)
    o = rmsnorm(o, p['gdn_norm']) * jax.nn.silu(z.reshape(b, t, GDN_HEADS, GDN_DV).astype(jnp.float32))
    y_a = o.reshape(b, t, GDN_HEADS * GDN_DV).astype(h.dtype) @ p['w_gdn_out']
    u, sbuf_new = causal_dwconv(sC * sx, sbuf, p['w_sc_conv'])
    y_b = (sB * u) @ p['w_sc_out']
    y = jax.nn.sigmoid(gA) * y_a + jax.nn.sigmoid(gB) * y_b
    return y @ p['w_mix_out'], S_new, gbuf_new, sbuf_new


def memory_kv(mem, p):
    b, m, _ = mem.shape
    k, v = jnp.split(rmsnorm(mem, p['n_mem']) @ p['w_xkv'], 2, axis=-1)
    return k.reshape(b, m, XA_HEADS, XA_DIM), v.reshape(b, m, XA_HEADS, XA_DIM)


def cross_attn(h, mk, mv, p):
    b, t, _ = h.shape
    q = (h @ p['w_xq']).reshape(b, t, XA_HEADS, XA_DIM)
    s = jnp.einsum('bthd,bmhd->bhtm', q, mk.astype(h.dtype)).astype(jnp.float32) * (XA_DIM ** -0.5)
    pr = jax.nn.softmax(s, axis=-1).astype(h.dtype)
    o = jnp.einsum('bhtm,bmhd->bthd', pr, mv.astype(h.dtype)).reshape(b, t, D_MODEL)
    return o @ p['w_xo']


def layer(x, mk, mv, S, gbuf, sbuf, p):
    x = x + 0.5 * rmsnorm(swiglu(rmsnorm(x, p['n_ffn1_pre']), p['w_ffn1_in'], p['w_ffn1_out']), p['n_ffn1_post'])
    m, S, gbuf, sbuf = token_mixer(rmsnorm(x, p['n_mix_pre']), S, gbuf, sbuf, p)
    x = x + rmsnorm(m, p['n_mix_post'])
    x = x + rmsnorm(cross_attn(rmsnorm(x, p['n_x_pre']), mk, mv, p), p['n_x_post'])
    x = x + 0.5 * rmsnorm(swiglu(rmsnorm(x, p['n_ffn2_pre']), p['w_ffn2_in'], p['w_ffn2_out']), p['n_ffn2_post'])
    return x, S, gbuf, sbuf


def setup_inputs(seed: int = 0) -> dict:
    key = jax.random.key(seed)
    ks = jax.random.split(key, 34)
    f32 = jnp.float32

    def nrm(i, shape, scale):
        return jax.random.normal(ks[i], shape, f32) * scale

    def wt(i, shape, fan_in):
        return nrm(i, (DEPTH,) + shape, fan_in ** -0.5)

    def gain(i, n):
        return 1.0 + nrm(i, (DEPTH, n), 0.02)

    a_log = jnp.log(jax.random.uniform(ks[15], (DEPTH, GDN_HEADS), f32, 1.0, 16.0))
    dt = jnp.exp(jax.random.uniform(ks[16], (DEPTH, GDN_HEADS), f32, float(np.log(1e-3)), float(np.log(1e-1))))
    dt_bias = dt + jnp.log(-jnp.expm1(-dt))
    return {
        'x_prompt': nrm(0, (BATCH, SEQ, D_MODEL), 1.0),
        'x_sample': nrm(1, (DEC_BATCH, DEC_SEQ, D_MODEL), 1.0),
        'mem_prompt': nrm(2, (BATCH, N_MEM, D_MODEL), 1.0),
        'cache_mem_k': nrm(3, (DEPTH, DEC_BATCH, N_MEM, XA_HEADS, XA_DIM), 1.0),
        'cache_mem_v': nrm(4, (DEPTH, DEC_BATCH, N_MEM, XA_HEADS, XA_DIM), 1.0),
        'state_gdn': nrm(5, (DEPTH, DEC_BATCH, GDN_HEADS, GDN_DK, GDN_DV), 0.1),
        'state_gdn_conv': nrm(6, (DEPTH, DEC_BATCH, GDN_CONV - 1, GDN_QKV), 1.0),
        'state_shortconv': nrm(7, (DEPTH, DEC_BATCH, SC_CONV - 1, SC_WIDTH), 0.5),
        'n_ffn1_pre': gain(8, D_MODEL),
        'w_ffn1_in': wt(9, (D_MODEL, 2 * D_FF), D_MODEL),
        'w_ffn1_out': wt(10, (D_FF, D_MODEL), D_FF),
        'n_ffn1_post': gain(11, D_MODEL),
        'n_mix_pre': gain(12, D_MODEL),
        'w_mix_in': wt(13, (D_MODEL, MIX_IN), D_MODEL),
        'w_gdn_conv': wt(14, (GDN_CONV, GDN_QKV), GDN_CONV),
        'gdn_a_log': a_log,
        'gdn_dt_bias': dt_bias,
        'gdn_norm': gain(17, GDN_DV),
        'w_gdn_out': wt(18, (GDN_HEADS * GDN_DV, D_MODEL), GDN_HEADS * GDN_DV),
        'w_sc_conv': wt(19, (SC_CONV, SC_WIDTH), SC_CONV),
        'w_sc_out': wt(20, (SC_WIDTH, D_MODEL), SC_WIDTH),
        'w_mix_out': wt(21, (D_MODEL, D_MODEL), D_MODEL),
        'n_mix_post': gain(22, D_MODEL),
        'n_x_pre': gain(23, D_MODEL),
        'n_mem': gain(24, D_MODEL),
        'w_xq': wt(25, (D_MODEL, D_MODEL), D_MODEL),
        'w_xkv': wt(26, (D_MODEL, 2 * D_MODEL), D_MODEL),
        'w_xo': wt(27, (D_MODEL, D_MODEL), D_MODEL),
        'n_x_post': gain(28, D_MODEL),
        'n_ffn2_pre': gain(29, D_MODEL),
        'w_ffn2_in': wt(30, (D_MODEL, 2 * D_FF), D_MODEL),
        'w_ffn2_out': wt(31, (D_FF, D_MODEL), D_FF),
        'n_ffn2_post': gain(32, D_MODEL),
    }


def reference(x_prompt, x_sample, mem_prompt, cache_mem_k, cache_mem_v, state_gdn, state_gdn_conv,
              state_shortconv, n_ffn1_pre, w_ffn1_in, w_ffn1_out, n_ffn1_post, n_mix_pre, w_mix_in,
              w_gdn_conv, gdn_a_log, gdn_dt_bias, gdn_norm, w_gdn_out, w_sc_conv, w_sc_out, w_mix_out,
              n_mix_post, n_x_pre, n_mem, w_xq, w_xkv, w_xo, n_x_post, n_ffn2_pre, w_ffn2_in, w_ffn2_out,
              n_ffn2_post):
    params = dict(n_ffn1_pre=n_ffn1_pre, w_ffn1_in=w_ffn1_in, w_ffn1_out=w_ffn1_out, n_ffn1_post=n_ffn1_post,
                  n_mix_pre=n_mix_pre, w_mix_in=w_mix_in, w_gdn_conv=w_gdn_conv, gdn_a_log=gdn_a_log,
                  gdn_dt_bias=gdn_dt_bias, gdn_norm=gdn_norm, w_gdn_out=w_gdn_out, w_sc_conv=w_sc_conv,
                  w_sc_out=w_sc_out, w_mix_out=w_mix_out, n_mix_post=n_mix_post, n_x_pre=n_x_pre,
                  n_mem=n_mem, w_xq=w_xq, w_xkv=w_xkv, w_xo=w_xo, n_x_post=n_x_post,
                  n_ffn2_pre=n_ffn2_pre, w_ffn2_in=w_ffn2_in, w_ffn2_out=w_ffn2_out, n_ffn2_post=n_ffn2_post)
    bp = x_prompt.shape[0]
    yp, ys = x_prompt, x_sample
    gdn_p, gconv_p, sconv_p, mk_p_all, mv_p_all = [], [], [], [], []
    gdn_s, gconv_s, sconv_s = [], [], []
    for l in range(DEPTH):
        p = {name: arr[l] for name, arr in params.items()}
        mk_p, mv_p = memory_kv(mem_prompt, p)
        s0 = jnp.zeros((bp, GDN_HEADS, GDN_DK, GDN_DV), jnp.float32)
        gb0 = jnp.zeros((bp, GDN_CONV - 1, GDN_QKV), x_prompt.dtype)
        sb0 = jnp.zeros((bp, SC_CONV - 1, SC_WIDTH), x_prompt.dtype)
        yp, sp, gbp, sbp = layer(yp, mk_p, mv_p, s0, gb0, sb0, p)
        ys, ss, gbs, sbs = layer(ys, cache_mem_k[l], cache_mem_v[l], state_gdn[l], state_gdn_conv[l],
                                 state_shortconv[l], p)
        gdn_p.append(sp); gconv_p.append(gbp); sconv_p.append(sbp)
        mk_p_all.append(mk_p); mv_p_all.append(mv_p)
        gdn_s.append(ss); gconv_s.append(gbs); sconv_s.append(sbs)
    return (yp, ys, jnp.stack(gdn_p), jnp.stack(gconv_p), jnp.stack(sconv_p), jnp.stack(mk_p_all),
            jnp.stack(mv_p_all), jnp.stack(gdn_s), jnp.stack(gconv_s), jnp.stack(sconv_s))
```

```cpp
#include <hip/hip_runtime.h>
#include <hip/hip_cooperative_groups.h>
#include <cstdio>
namespace cg = cooperative_groups;

#ifndef MK_SINGLE
#define MK_SINGLE 1
#endif
#ifndef MK_PLIMIT
#define MK_PLIMIT 99

#endif

#define LAS __attribute__((address_space(3)))
typedef unsigned short bf16_t;
typedef short bf16x8 __attribute__((ext_vector_type(8)));
typedef float f32x4 __attribute__((ext_vector_type(4)));
typedef unsigned u32x4 __attribute__((ext_vector_type(4)));
typedef unsigned u32x2 __attribute__((ext_vector_type(2)));

constexpr int M_TOK = 66560, NCH = 1040, NPROMPT = 65536;
constexpr size_t SLOT_E = (size_t)M_TOK * 1024;
constexpr size_t SLOT_B = SLOT_E * 2;
constexpr int LDS_BYTES = 147456;
constexpr int NPHASE = 26;

constexpr size_t WB_F1A = 0, WB_F1B = 5767168, WB_QKV = 8650752, WB_MIX2 = 11796480, WB_SB = 17039360, WB_GO = 18087936,
                 WB_SCO = 19136512, WB_MO = 20185088, WB_XQ = 21233664, WB_XKV = 22282240, WB_XO = 24379392, WB_F2A = 25427968, WB_F2B = 31195136;
constexpr size_t OFF_WB = 0, OFF_G = 68157440, OFF_BETA = 70287360, OFF_GC = 72417280, OFF_SSQ = 74547200  , OFF_MH = 74547200,
                 OFF_KX = 78741504, OFF_VXT = 91324416, OFF_SLOTS = 103907328, OFF_BAR = OFF_SLOTS + 7 * SLOT_B, WS_END = OFF_BAR + 16384;
constexpr size_t O_GSP = 68157440, O_GCP = 69206016, O_SCP = 69279744, O_MK = 69296128, O_MV = 71393280, O_GSS = 73490432, O_GCS = 75587584, O_SCS = 75735040;

typedef float f32x2v __attribute__((ext_vector_type(2)));
typedef __bf16 bf16x2v __attribute__((ext_vector_type(2)));
__device__ __forceinline__ unsigned pk2n(float lo, float hi) { const f32x2v v = {lo, hi}; const bf16x2v b = __builtin_convertvector(v, bf16x2v); return __builtin_bit_cast(unsigned, b); }
__device__ __forceinline__ unsigned pk2(float lo, float hi) { unsigned r; asm volatile("s_nop 1\n\tv_cvt_pk_bf16_f32 %0, %1, %2" : "=v"(r) : "v"(lo), "v"(hi)); return r; }
__device__ __forceinline__ float bf2f(bf16_t h) { return __uint_as_float((unsigned)h << 16); }
__device__ __forceinline__ float bflo(unsigned w) { return __uint_as_float(w << 16); }
__device__ __forceinline__ float bfhi(unsigned w) { return __uint_as_float(w & 0xffff0000u); }
__device__ __forceinline__ float silu_f(float x) { return x * __builtin_amdgcn_rcpf(1.f + __expf(-x)); }
__device__ __forceinline__ float sigm_f(float x) { return __builtin_amdgcn_rcpf(1.f + __expf(-x)); }
__device__ __forceinline__ f32x4 mfma16(bf16x8 a, bf16x8 b, f32x4 c) { return __builtin_amdgcn_mfma_f32_16x16x32_bf16(a, b, c, 0, 0, 0); }
__device__ __forceinline__ bf16x8 as_bf(u32x4 v) { return __builtin_bit_cast(bf16x8, v); }
__device__ __forceinline__ void seq_of_row(int row, int& sb, int& t, int& T, int& sidx) {
    if (row < NPROMPT) { sb = -1; sidx = row >> 13; t = row & 8191; T = 8192; } else { const int q = row - NPROMPT; sb = q >> 6; sidx = sb; t = q & 63; T = 64; }
}

namespace pg8 {
constexpr int BM = 256, BK = 64, HALF = 128, HTB = HALF * BK * 2, STAGE_BYTES = 8 * HTB, NXCD = 8, WGM = 8;
__host__ __device__ __forceinline__ int lds_byte(int r, int c) { const int st = (r >> 4) * 2 + (c >> 5), rr = r & 15, cc = c & 31, ob = rr * 64 + cc * 2; return st * 1024 + (ob ^ (((ob >> 9) & 1) << 5)); }
__host__ __device__ __forceinline__ void stage_rc(int b, int& R, int& C) { const int st = b / 1024, sb = b % 1024, swz = sb ^ (((sb >> 9) & 1) << 5); R = (st >> 1) * 16 + swz / 64; C = (st & 1) * 32 + (swz % 64) / 2; }
__host__ __device__ __forceinline__ int perm32(int rho) { const int n = rho >> 4, i = rho & 15; return 8 * (i >> 2) + 4 * n + (i & 3); }
struct Unit { int pm, pn; };
struct Gemm { const bf16_t* A; const bf16_t* Bt; int M, N, K; };
struct StaticOrder {
    int nM, nN, nwg, G, c;
    __device__ void init(int M, int N, int G_, int c_) { nM = M / BM; nN = N / BM; nwg = nM * nN; G = G_; c = c_; }
    __device__ bool next(int i, Unit& u) const {
        const long L = (long)i * G + c; if (L >= nwg) return false;
        int wgid = (int)L; { const int q = nwg / NXCD, r = nwg % NXCD, xcd = wgid % NXCD, off = wgid / NXCD; wgid = (xcd < r ? xcd * (q + 1) : r * (q + 1) + (xcd - r) * q) + off; }
        const int nig = WGM * nN, gid = wgid / nig, fm = gid * WGM, gsz = (nM - fm) < WGM ? (nM - fm) : WGM;
        u.pm = fm + ((wgid % nig) % gsz); u.pn = (wgid % nig) / gsz; return true;
    }
};

enum { M_SWIGLU = 0, M_BF16 = 1, M_MIX2 = 2, M_SB = 3, M_GDNOUT = 4, M_SCOUT = 5, M_F32 = 6, M_KV = 7, M_ZOG = 8 };
struct EpiArgs {
    int mode; float scale; int act;
    bf16_t* o0; bf16_t* o1; bf16_t* o2; bf16_t* o3;
    const bf16_t* a0;
    const float* f0; const float* f1;
    float* fo0; float* fo1;
};

__device__ __forceinline__ void epi_perm(const EpiArgs E, const f32x4 (&acc)[2][2][4][2], const Unit& u, int wr, int wc, int fr, int fq) {
    const int row0 = u.pm * BM + wr * 64 + fr, c8 = wc * 32 + 8 * fq;
    if (E.mode == M_SWIGLU) {
#pragma unroll
        for (int ai = 0; ai < 2; ++ai)
#pragma unroll
            for (int m = 0; m < 4; ++m) {
                const int row = row0 + ai * HALF + m * 16; float o[8];
#pragma unroll
                for (int n = 0; n < 2; ++n)
#pragma unroll
                    for (int j = 0; j < 4; ++j) o[n * 4 + j] = silu_f(acc[ai][0][m][n][j]) * acc[ai][1][m][n][j];
                u32x4 w; w.x = pk2(o[0], o[1]); w.y = pk2(o[2], o[3]); w.z = pk2(o[4], o[5]); w.w = pk2(o[6], o[7]);
                *(u32x4*)(E.o0 + (size_t)row * 2816 + u.pn * 128 + c8) = w;
            }
    } else if (E.mode == M_BF16) {
        bf16_t* base = E.o0 + (size_t)(u.pn >> 2) * SLOT_E; const int colt = (u.pn & 3) * 256; const float s = E.scale;
#pragma unroll
        for (int ai = 0; ai < 2; ++ai)
#pragma unroll
            for (int m = 0; m < 4; ++m) {
                const int row = row0 + ai * HALF + m * 16;
#pragma unroll
                for (int bj = 0; bj < 2; ++bj) {
                    f32x4 v0 = acc[ai][bj][m][0] * s, v1 = acc[ai][bj][m][1] * s;
                    if (E.act == 1) {
#pragma unroll
                        for (int j = 0; j < 4; ++j) { v0[j] = silu_f(v0[j]); v1[j] = silu_f(v1[j]); } }
                    if (E.act == 2) {
#pragma unroll
                        for (int j = 0; j < 4; ++j) { v0[j] = sigm_f(v0[j]); v1[j] = sigm_f(v1[j]); } }
                    u32x4 w; w.x = pk2(v0[0], v0[1]); w.y = pk2(v0[2], v0[3]); w.z = pk2(v1[0], v1[1]); w.w = pk2(v1[2], v1[3]);
                    *(u32x4*)(base + (size_t)row * 1024 + colt + bj * HALF + c8) = w;
                }
            }
    } else if (E.mode == M_MIX2) {
        const int cc = u.pn * 128 + c8;
#pragma unroll
        for (int ai = 0; ai < 2; ++ai)
#pragma unroll
            for (int m = 0; m < 4; ++m) {
                const int row = row0 + ai * HALF + m * 16; float o[8];
#pragma unroll
                for (int n = 0; n < 2; ++n)
#pragma unroll
                    for (int j = 0; j < 4; ++j) o[n * 4 + j] = acc[ai][0][m][n][j] * acc[ai][1][m][n][j];
                u32x4 w; w.x = pk2(o[0], o[1]); w.y = pk2(o[2], o[3]); w.z = pk2(o[4], o[5]); w.w = pk2(o[6], o[7]);
                *(u32x4*)(E.o0 + (size_t)row * 1024 + cc) = w;
            }
    } else if (E.mode == M_ZOG) {
#pragma unroll
        for (int bj = 0; bj < 2; ++bj) {
            const int head = u.pn * 2 + bj;
            const f32x4 g0 = *(const f32x4*)(E.f1 + c8), g1 = *(const f32x4*)(E.f1 + c8 + 4);
#pragma unroll
            for (int ai = 0; ai < 2; ++ai)
#pragma unroll
                for (int m = 0; m < 4; ++m) {
                    const int row = row0 + ai * HALF + m * 16;
                    const u32x4 ov = __builtin_nontemporal_load((const u32x4*)(E.a0 + ((size_t)((row >> 6) * 8 + head) * 64) * 128 + (c8 >> 5) * 2048 + (row & 63) * 32 + (c8 & 31)));
                    const f32x4 s0 = *(const f32x4*)(E.f0 + ((size_t)row * 8 + head) * 8), s1 = *(const f32x4*)(E.f0 + ((size_t)row * 8 + head) * 8 + 4);
                    const float ss = (s0[0] + s0[1]) + (s0[2] + s0[3]) + (s1[0] + s1[1]) + (s1[2] + s1[3]);
                    const float rs = rsqrtf(ss * (1.0f / 128.0f) + 1e-6f);
                    const f32x4 z0 = acc[ai][bj][m][0], z1 = acc[ai][bj][m][1];
                    float o[8];
                    o[0] = bflo(ov.x) * rs * g0[0] * silu_f(z0[0]); o[1] = bfhi(ov.x) * rs * g0[1] * silu_f(z0[1]);
                    o[2] = bflo(ov.y) * rs * g0[2] * silu_f(z0[2]); o[3] = bfhi(ov.y) * rs * g0[3] * silu_f(z0[3]);
                    o[4] = bflo(ov.z) * rs * g1[0] * silu_f(z1[0]); o[5] = bfhi(ov.z) * rs * g1[1] * silu_f(z1[1]);
                    o[6] = bflo(ov.w) * rs * g1[2] * silu_f(z1[2]); o[7] = bfhi(ov.w) * rs * g1[3] * silu_f(z1[3]);
                    u32x4 w; w.x = pk2(o[0], o[1]); w.y = pk2(o[2], o[3]); w.z = pk2(o[4], o[5]); w.w = pk2(o[6], o[7]);
                    *(u32x4*)(E.o0 + (size_t)row * 1024 + head * 128 + c8) = w;
                }
        }
    } else if (E.mode == M_SB) {
#pragma unroll
        for (int bj = 0; bj < 2; ++bj) {
            const int col = u.pn * 256 + bj * HALF + c8;
            float wc3[3][8];
#pragma unroll
            for (int i = 0; i < 3; ++i) { const f32x4 a = *(const f32x4*)(E.f0 + i * 1024 + col), b = *(const f32x4*)(E.f0 + i * 1024 + col + 4);
                wc3[i][0] = a[0]; wc3[i][1] = a[1]; wc3[i][2] = a[2]; wc3[i][3] = a[3]; wc3[i][4] = b[0]; wc3[i][5] = b[1]; wc3[i][6] = b[2]; wc3[i][7] = b[3]; }
#pragma unroll
            for (int ai = 0; ai < 2; ++ai)
#pragma unroll
                for (int m = 0; m < 4; ++m) {
                    const int row = row0 + ai * HALF + m * 16;
                    int sb, t, T, sidx; seq_of_row(row, sb, t, T, sidx);
                    float uu[8];
#pragma unroll
                    for (int e = 0; e < 8; ++e) uu[e] = 0.f;
#pragma unroll
                    for (int i = 0; i < 3; ++i) {
                        const int tt = t - 2 + i; const bool inseq = tt >= 0; const bool usebuf = (!inseq) && (sb >= 0);
                        const int rowp = inseq ? (row - 2 + i) : row;
                        const int bidx = (sb >= 0 ? sb : 0) * 2 + (inseq ? 0 : tt + 2);
                        const u32x4 pv = *(const u32x4*)(E.a0 + (size_t)rowp * 1024 + col);
                        const float* bp = E.f1 + (size_t)bidx * 1024 + col; const f32x4 a = *(const f32x4*)bp, b = *(const f32x4*)(bp + 4);
                        float x[8];
                        x[0] = inseq ? bflo(pv.x) : (usebuf ? a[0] : 0.f); x[1] = inseq ? bfhi(pv.x) : (usebuf ? a[1] : 0.f);
                        x[2] = inseq ? bflo(pv.y) : (usebuf ? a[2] : 0.f); x[3] = inseq ? bfhi(pv.y) : (usebuf ? a[3] : 0.f);
                        x[4] = inseq ? bflo(pv.z) : (usebuf ? b[0] : 0.f); x[5] = inseq ? bfhi(pv.z) : (usebuf ? b[1] : 0.f);
                        x[6] = inseq ? bflo(pv.w) : (usebuf ? b[2] : 0.f); x[7] = inseq ? bfhi(pv.w) : (usebuf ? b[3] : 0.f);
#pragma unroll
                        for (int e = 0; e < 8; ++e) uu[e] += wc3[i][e] * x[e];
                    }
                    const f32x4 v0 = acc[ai][bj][m][0], v1 = acc[ai][bj][m][1];
                    u32x4 w; w.x = pk2(v0[0] * uu[0], v0[1] * uu[1]); w.y = pk2(v0[2] * uu[2], v0[3] * uu[3]); w.z = pk2(v1[0] * uu[4], v1[1] * uu[5]); w.w = pk2(v1[2] * uu[6], v1[3] * uu[7]);
                    *(u32x4*)(E.o0 + (size_t)row * 1024 + col) = w;
                }
        }
    } else {
        const bool sc = (E.mode == M_SCOUT);
#pragma unroll
        for (int ai = 0; ai < 2; ++ai)
#pragma unroll
            for (int m = 0; m < 4; ++m) {
                const int row = row0 + ai * HALF + m * 16;
#pragma unroll
                for (int bj = 0; bj < 2; ++bj) {
                    const size_t off = (size_t)row * 1024 + u.pn * 256 + bj * HALF + c8;
                    const u32x4 yv = __builtin_nontemporal_load((const u32x4*)(E.o0 + off));
                    const f32x4 v0 = acc[ai][bj][m][0], v1 = acc[ai][bj][m][1];
                    float o[8];
                    if (sc) { const u32x4 gv = __builtin_nontemporal_load((const u32x4*)(E.a0 + off));
                        o[0] = bflo(yv.x) + bflo(gv.x) * v0[0]; o[1] = bfhi(yv.x) + bfhi(gv.x) * v0[1]; o[2] = bflo(yv.y) + bflo(gv.y) * v0[2]; o[3] = bfhi(yv.y) + bfhi(gv.y) * v0[3];
                        o[4] = bflo(yv.z) + bflo(gv.z) * v1[0]; o[5] = bfhi(yv.z) + bfhi(gv.z) * v1[1]; o[6] = bflo(yv.w) + bflo(gv.w) * v1[2]; o[7] = bfhi(yv.w) + bfhi(gv.w) * v1[3];
                    } else {
                        o[0] = bflo(yv.x) * v0[0]; o[1] = bfhi(yv.x) * v0[1]; o[2] = bflo(yv.y) * v0[2]; o[3] = bfhi(yv.y) * v0[3];
                        o[4] = bflo(yv.z) * v1[0]; o[5] = bfhi(yv.z) * v1[1]; o[6] = bflo(yv.w) * v1[2]; o[7] = bfhi(yv.w) * v1[3];
                    }
                    u32x4 w; w.x = pk2(o[0], o[1]); w.y = pk2(o[2], o[3]); w.z = pk2(o[4], o[5]); w.w = pk2(o[6], o[7]);
                    *(u32x4*)(E.o0 + off) = w;
                }
            }
    }
}
__device__ __forceinline__ void epi_plain(const EpiArgs E, const f32x4 (&acc)[2][2][4][2], const Unit& u, int wr, int wc, int fr, int fq) {
    const int row0 = u.pm * BM + wr * 64 + fr, col0 = u.pn * BM + wc * 32 + 4 * fq;
    if (E.mode == M_F32) {
#pragma unroll
        for (int ai = 0; ai < 2; ++ai)
#pragma unroll
            for (int m = 0; m < 4; ++m) { float* rowp = E.fo0 + (size_t)(row0 + ai * HALF + m * 16) * 1024 + col0;
#pragma unroll
                for (int bj = 0; bj < 2; ++bj)
#pragma unroll
                    for (int n = 0; n < 2; ++n) *(f32x4*)(rowp + bj * HALF + n * 16) = acc[ai][bj][m][n]; }
    } else {
#pragma unroll
        for (int ai = 0; ai < 2; ++ai)
#pragma unroll
            for (int m = 0; m < 4; ++m) { const int row = row0 + ai * HALF + m * 16;
#pragma unroll
                for (int bj = 0; bj < 2; ++bj)
#pragma unroll
                    for (int n = 0; n < 2; ++n) { const int c = col0 + bj * HALF + n * 16; const f32x4 v = acc[ai][bj][m][n];
                        if (c < 1024) { *(f32x4*)(E.fo0 + (size_t)row * 1024 + c) = v; u32x2 w; w.x = pk2(v[0], v[1]); w.y = pk2(v[2], v[3]); *(u32x2*)(E.o0 + (size_t)row * 1024 + c) = w; }
                        else { const int c2 = c - 1024; *(f32x4*)(E.fo1 + (size_t)row * 1024 + c2) = v; const int seq = row >> 8, key = row & 255, hh = c2 >> 8, dim = c2 & 255;
                            bf16_t* d = E.o1 + ((size_t)((seq * 4 + hh) * 256 + dim)) * 256 + key;
                            d[0] = (bf16_t)(pk2(v[0], v[0]) & 0xffffu); d[256] = (bf16_t)(pk2(v[1], v[1]) & 0xffffu); d[512] = (bf16_t)(pk2(v[2], v[2]) & 0xffffu); d[768] = (bf16_t)(pk2(v[3], v[3]) & 0xffffu); } } }
    }
}

template <bool PERM>
__device__ __forceinline__ void gemm_phase(LAS unsigned char* lds, const Gemm g, const StaticOrder S, const EpiArgs E) {
    const int tid = threadIdx.x, wid = __builtin_amdgcn_readfirstlane(tid >> 6), lane = tid & 63, wr = wid >> 2, wc = wid & 3, fr = lane & 15, fq = lane >> 4;
    const int K = g.K, nt = K / BK;
    unsigned voffA[2], voffB[2];
#pragma unroll
    for (int i = 0; i < 2; ++i) { int R, C; stage_rc(tid * 16 + i * 8192, R, C); const int Rb = PERM ? ((R & ~31) + perm32(R & 31)) : R;
        voffA[i] = (unsigned)(R * K + C) * 2u; voffB[i] = (unsigned)(Rb * K + C) * 2u; }
    const size_t kstep = (size_t)(BK * 2);
    const size_t hstep = (size_t)HALF * K * 2;
    const size_t tstep = 2 * hstep;
    const unsigned ldsw = (unsigned)wid * 1024u;
    const int aoff = lds_byte(wr * 64 + fr, fq * 8), boff = lds_byte(wc * 32 + fr, fq * 8);
#define PG8_SA(b, h) (((b) * 2 + (h)) * HTB)
#define PG8_SB(b, h) ((4 + (b) * 2 + (h)) * HTB)
#define PG8_STAGE(bufoff, gbase, voff) do { _Pragma("unroll") for (int _i = 0; _i < 2; ++_i) \
        __builtin_amdgcn_global_load_lds((const unsigned*)((const char*)(gbase) + (voff)[_i]), (LAS unsigned*)(lds + (bufoff) + ldsw + _i * 8192), 16, 0, 0); } while (0)
#define PG8_LDA(dst, b, h) do { _Pragma("unroll") for (int m = 0; m < 4; ++m) _Pragma("unroll") for (int k = 0; k < 2; ++k) dst[m][k] = *(const LAS bf16x8*)(lds + PG8_SA(b, h) + aoff + m * 2048 + k * 1024); } while (0)
#define PG8_LDB(dst, b, h) do { _Pragma("unroll") for (int n = 0; n < 2; ++n) _Pragma("unroll") for (int k = 0; k < 2; ++k) dst[n][k] = *(const LAS bf16x8*)(lds + PG8_SB(b, h) + boff + n * 2048 + k * 1024); } while (0)
#define PG8_MMA(ai, bj, At, Bt) do { __builtin_amdgcn_s_setprio(1); _Pragma("unroll") for (int m = 0; m < 4; ++m) _Pragma("unroll") for (int n = 0; n < 2; ++n) _Pragma("unroll") for (int k = 0; k < 2; ++k) \
        acc[ai][bj][m][n] = __builtin_amdgcn_mfma_f32_16x16x32_bf16(Bt[n][k], At[m][k], acc[ai][bj][m][n], 0, 0, 0); __builtin_amdgcn_s_setprio(0); } while (0)
#define PG8_WAIT_V(n) asm volatile("s_waitcnt vmcnt(" #n ")" ::: "memory")
#define PG8_WAIT_L(n) asm volatile("s_waitcnt lgkmcnt(" #n ")" ::: "memory")
#define PG8_BAR __builtin_amdgcn_s_barrier()
#define PG8_SCHED __builtin_amdgcn_sched_barrier(0)
    Unit cur, nxt; int ui = 0;
    if (!S.next(0, cur)) return;
    f32x4 acc[2][2][4][2];
#pragma unroll
    for (int a = 0; a < 2; ++a)
#pragma unroll
        for (int b = 0; b < 2; ++b)
#pragma unroll
            for (int m = 0; m < 4; ++m)
#pragma unroll
                for (int n = 0; n < 2; ++n) acc[a][b][m][n] = (f32x4){0.f, 0.f, 0.f, 0.f};
    bf16x8 At[4][2], B0[2][2], B1[2][2];
    const char* cA = (const char*)g.A + (size_t)cur.pm * tstep; const char* cB = (const char*)g.Bt + (size_t)cur.pn * tstep;
    PG8_STAGE(PG8_SB(0, 0), cB, voffB); PG8_STAGE(PG8_SB(0, 1), cB + hstep, voffB); PG8_STAGE(PG8_SA(0, 0), cA, voffA); PG8_STAGE(PG8_SA(0, 1), cA + hstep, voffA);
    if (wr == 1) PG8_BAR;
    PG8_WAIT_V(0); PG8_BAR;
    PG8_STAGE(PG8_SB(1, 0), cB + kstep, voffB); PG8_STAGE(PG8_SA(1, 0), cA + kstep, voffA); PG8_STAGE(PG8_SB(1, 1), cB + hstep + kstep, voffB);
    PG8_WAIT_V(0); PG8_BAR;
    for (;;) {
        const bool has_next = S.next(ui + 1, nxt);
        const char* nA = has_next ? (const char*)g.A + (size_t)nxt.pm * tstep : cA; const char* nB = has_next ? (const char*)g.Bt + (size_t)nxt.pn * tstep : cB;
        for (int t = 0; t < nt; t += 2) {
            const bool last = (t == nt - 2);
            const char* a1 = cA + (size_t)(t + 1) * kstep;
            const char* a2 = last ? nA : cA + (size_t)(t + 2) * kstep; const char* b2 = last ? nB : cB + (size_t)(t + 2) * kstep;
            const char* a3 = a2 + kstep; const char* b3 = b2 + kstep;
            PG8_LDB(B0, 0, 0); PG8_LDB(B1, 0, 1); PG8_SCHED; PG8_LDA(At, 0, 0); PG8_STAGE(PG8_SA(1, 1), a1 + hstep, voffA);
            PG8_WAIT_V(8); PG8_WAIT_L(0); PG8_BAR; PG8_MMA(0, 0, At, B0); PG8_MMA(0, 1, At, B1); PG8_BAR; PG8_SCHED;
            PG8_LDA(At, 0, 1); PG8_STAGE(PG8_SB(0, 0), b2, voffB); PG8_STAGE(PG8_SB(0, 1), b2 + hstep, voffB); PG8_STAGE(PG8_SA(0, 0), a2, voffA);
            PG8_WAIT_V(8); PG8_WAIT_L(0); PG8_BAR; PG8_MMA(1, 0, At, B0); PG8_MMA(1, 1, At, B1); PG8_BAR; PG8_SCHED;
            PG8_LDB(B0, 1, 0); PG8_LDB(B1, 1, 1); PG8_SCHED; PG8_LDA(At, 1, 0); PG8_STAGE(PG8_SA(0, 1), a2 + hstep, voffA);
            PG8_WAIT_V(8); PG8_WAIT_L(0); PG8_BAR; PG8_MMA(0, 0, At, B0); PG8_MMA(0, 1, At, B1); PG8_BAR; PG8_SCHED;
            PG8_LDA(At, 1, 1); PG8_STAGE(PG8_SB(1, 0), b3, voffB); PG8_STAGE(PG8_SB(1, 1), b3 + hstep, voffB); PG8_STAGE(PG8_SA(1, 0), a3, voffA);
            PG8_WAIT_V(8); PG8_WAIT_L(0); PG8_BAR; PG8_MMA(1, 0, At, B0); PG8_MMA(1, 1, At, B1); PG8_BAR; PG8_SCHED;
        }
        if (wr == 0) PG8_BAR;
        if (PERM) epi_perm(E, acc, cur, wr, wc, fr, fq); else epi_plain(E, acc, cur, wr, wc, fr, fq);
        if (!has_next) break;
#pragma unroll
        for (int a = 0; a < 2; ++a)
#pragma unroll
            for (int b = 0; b < 2; ++b)
#pragma unroll
                for (int m = 0; m < 4; ++m)
#pragma unroll
                    for (int n = 0; n < 2; ++n) acc[a][b][m][n] = (f32x4){0.f, 0.f, 0.f, 0.f};
        cur = nxt; cA = nA; cB = nB; ++ui;
        if (wr == 1) PG8_BAR;
    }
    PG8_WAIT_V(0);
    PG8_BAR;
#undef PG8_SA
#undef PG8_SB
#undef PG8_STAGE
#undef PG8_LDA
#undef PG8_LDB
#undef PG8_MMA
#undef PG8_WAIT_V
#undef PG8_WAIT_L
#undef PG8_BAR
#undef PG8_SCHED
}
}

__device__ __forceinline__ void cvt_job(LAS unsigned char* lds, const float* __restrict__ src, int K, int ld, int N, int mode, int coloff, int halfoff, bf16_t* __restrict__ dst) {
    LAS float* tile0 = (LAS float*)lds;
    const int tid = threadIdx.x;
    const int nkt = K / 64, ntile = nkt * (N / 64);
    for (int t = blockIdx.x; t < ntile; t += 2 * gridDim.x) {
#pragma unroll
        for (int u = 0; u < 2; ++u) {
            const int tt = t + u * gridDim.x;
            if (tt < ntile) {
                LAS float* tile = tile0 + u * 4160;
                const int kt = tt % nkt, ntl = tt / nkt; const int k0 = kt * 64, n0 = ntl * 64;
                int sc;
                if (mode == 0) sc = coloff + n0; else { const int j = n0 >> 8, r = n0 & 255; sc = coloff + j * 128 + (r < 128 ? r : halfoff + (r - 128)); }
                const int kr = tid >> 4, c4 = (tid & 15) * 4;
#pragma unroll
                for (int i = 0; i < 2; ++i) { const int k = kr + 32 * i; const f32x4 v = __builtin_nontemporal_load((const f32x4*)(src + (size_t)(k0 + k) * ld + sc + c4));
                    tile[k * 65 + c4] = v[0]; tile[k * 65 + c4 + 1] = v[1]; tile[k * 65 + c4 + 2] = v[2]; tile[k * 65 + c4 + 3] = v[3]; }
            }
        }
        __syncthreads();
#pragma unroll
        for (int u = 0; u < 2; ++u) {
            const int tt = t + u * gridDim.x;
            if (tt < ntile) {
                LAS float* tile = tile0 + u * 4160;
                const int kt = tt % nkt, ntl = tt / nkt; const int k0 = kt * 64, n0 = ntl * 64;
                const int n = tid >> 3, k8 = (tid & 7) * 8; float f[8];
#pragma unroll
                for (int e = 0; e < 8; ++e) f[e] = tile[(k8 + e) * 65 + n];
                u32x4 w; w.x = pk2(f[0], f[1]); w.y = pk2(f[2], f[3]); w.z = pk2(f[4], f[5]); w.w = pk2(f[6], f[7]);
                *(u32x4*)(dst + (size_t)(n0 + n) * K + k0 + k8) = w;
            }
        }
        __syncthreads();
    }
}

__device__ __forceinline__ float wave_sum(float s) {
#pragma unroll
    for (int o = 32; o > 0; o >>= 1) s += __shfl_xor(s, o);
    return s;
}
__device__ __forceinline__ void rowpass(LAS unsigned char* lds, const float* xin0, const float* xin1, const bf16_t* xinb, const bf16_t* T, const float* gpost, float scale,
                        float* Xout, bf16_t* Xoutb, const float* gpre, bf16_t* Hout, int nrows, bool ab, const float* wmix, const float* a_log, const float* dt_bias, float* G, float* BETA) {
    const int tid = threadIdx.x, lane = tid & 63, w = tid >> 6;
    LAS float* wT = (LAS float*)lds;
    if (ab) { for (int idx = tid; idx < 16384; idx += 512) { const int k = idx >> 4, j = idx & 15; const int rem = k & 511; wT[j * 1024 + (((k >> 9) * 2 + ((rem & 7) >> 2)) * 256) + (rem >> 3) * 4 + (rem & 3)] = wmix[(size_t)k * 9232 + 4096 + j]; } __syncthreads(); }
    float gp[16], gq[16];
#pragma unroll
    for (int i = 0; i < 2; ++i)
#pragma unroll
        for (int h4 = 0; h4 < 2; ++h4) { const int c = lane * 8 + i * 512 + h4 * 4;
            const f32x4 a = gpre ? *(const f32x4*)(gpre + c) : (f32x4){0.f, 0.f, 0.f, 0.f}, b = gpost ? *(const f32x4*)(gpost + c) : (f32x4){0.f, 0.f, 0.f, 0.f};
#pragma unroll
            for (int e = 0; e < 4; ++e) { gq[i * 8 + h4 * 4 + e] = a[e]; gp[i * 8 + h4 * 4 + e] = b[e]; } }
    for (int row = blockIdx.x * 8 + w; row < nrows; row += gridDim.x * 8) {
        float v[16];
        if (xinb) {
#pragma unroll
            for (int i = 0; i < 2; ++i) { const u32x4 xv = __builtin_nontemporal_load((const u32x4*)(xinb + (size_t)row * 1024 + lane * 8 + i * 512));
                v[i * 8 + 0] = bflo(xv.x); v[i * 8 + 1] = bfhi(xv.x); v[i * 8 + 2] = bflo(xv.y); v[i * 8 + 3] = bfhi(xv.y); v[i * 8 + 4] = bflo(xv.z); v[i * 8 + 5] = bfhi(xv.z); v[i * 8 + 6] = bflo(xv.w); v[i * 8 + 7] = bfhi(xv.w); }
        } else {
            const float* xr = row < NPROMPT ? xin0 + (size_t)row * 1024 : xin1 + (size_t)(row - NPROMPT) * 1024;
#pragma unroll
            for (int i = 0; i < 2; ++i)
#pragma unroll
                for (int h4 = 0; h4 < 2; ++h4) { const f32x4 a = __builtin_nontemporal_load((const f32x4*)(xr + lane * 8 + i * 512 + h4 * 4));
#pragma unroll
                    for (int e = 0; e < 4; ++e) v[i * 8 + h4 * 4 + e] = a[e]; }
        }
        if (T) {
            float t[16]; float ss = 0.f;
#pragma unroll
            for (int i = 0; i < 2; ++i) { const u32x4 tv = __builtin_nontemporal_load((const u32x4*)(T + (size_t)row * 1024 + lane * 8 + i * 512));
                t[i * 8 + 0] = bflo(tv.x); t[i * 8 + 1] = bfhi(tv.x); t[i * 8 + 2] = bflo(tv.y); t[i * 8 + 3] = bfhi(tv.y); t[i * 8 + 4] = bflo(tv.z); t[i * 8 + 5] = bfhi(tv.z); t[i * 8 + 6] = bflo(tv.w); t[i * 8 + 7] = bfhi(tv.w); }
#pragma unroll
            for (int e = 0; e < 16; ++e) ss += t[e] * t[e];
            ss = wave_sum(ss);
            const float r = rsqrtf(ss * (1.0f / 1024.0f) + 1e-6f) * scale;
#pragma unroll
            for (int e = 0; e < 16; ++e) v[e] += t[e] * gp[e] * r;
        }
        if (Xout) {
#pragma unroll
            for (int i = 0; i < 2; ++i)
#pragma unroll
                for (int h4 = 0; h4 < 2; ++h4) __builtin_nontemporal_store((f32x4){v[i * 8 + h4 * 4], v[i * 8 + h4 * 4 + 1], v[i * 8 + h4 * 4 + 2], v[i * 8 + h4 * 4 + 3]}, (f32x4*)(Xout + (size_t)row * 1024 + lane * 8 + i * 512 + h4 * 4));
        }
        if (Xoutb) {
#pragma unroll
            for (int i = 0; i < 2; ++i) { u32x4 xw; xw.x = pk2(v[i * 8], v[i * 8 + 1]); xw.y = pk2(v[i * 8 + 2], v[i * 8 + 3]); xw.z = pk2(v[i * 8 + 4], v[i * 8 + 5]); xw.w = pk2(v[i * 8 + 6], v[i * 8 + 7]);
                *(u32x4*)(Xoutb + (size_t)row * 1024 + lane * 8 + i * 512) = xw; }
        }
        if (Hout) {
            float ss = 0.f;
#pragma unroll
            for (int e = 0; e < 16; ++e) ss += v[e] * v[e];
            ss = wave_sum(ss);
            const float r2 = rsqrtf(ss * (1.0f / 1024.0f) + 1e-6f);
            float h[16];
#pragma unroll
            for (int e = 0; e < 16; ++e) h[e] = v[e] * gq[e] * r2;
#pragma unroll
            for (int i = 0; i < 2; ++i) { u32x4 hw; hw.x = pk2(h[i * 8], h[i * 8 + 1]); hw.y = pk2(h[i * 8 + 2], h[i * 8 + 3]); hw.z = pk2(h[i * 8 + 4], h[i * 8 + 5]); hw.w = pk2(h[i * 8 + 6], h[i * 8 + 7]);
                *(u32x4*)(Hout + (size_t)row * 1024 + lane * 8 + i * 512) = hw; }
            if (ab) {
                float p[16];
#pragma unroll
                for (int j = 0; j < 16; ++j) { float s = 0.f;
#pragma unroll
                    for (int i = 0; i < 2; ++i)
#pragma unroll
                        for (int h4 = 0; h4 < 2; ++h4) { const f32x4 wv = *(const LAS f32x4*)(wT + j * 1024 + (i * 2 + h4) * 256 + lane * 4);
                            s += h[i * 8 + h4 * 4] * wv[0] + h[i * 8 + h4 * 4 + 1] * wv[1] + h[i * 8 + h4 * 4 + 2] * wv[2] + h[i * 8 + h4 * 4 + 3] * wv[3]; }
                    p[j] = s; }
                const bool b32 = (lane & 32) != 0, b16 = (lane & 16) != 0, b8 = (lane & 8) != 0, b4 = (lane & 4) != 0;
                float q8[8], q4[4], q2[2];
#pragma unroll
                for (int k = 0; k < 8; ++k) { const float snd = b32 ? p[k] : p[k + 8]; const float r = __shfl_xor(snd, 32); q8[k] = (b32 ? p[k + 8] : p[k]) + r; }
#pragma unroll
                for (int k = 0; k < 4; ++k) { const float snd = b16 ? q8[k] : q8[k + 4]; const float r = __shfl_xor(snd, 16); q4[k] = (b16 ? q8[k + 4] : q8[k]) + r; }
#pragma unroll
                for (int k = 0; k < 2; ++k) { const float snd = b8 ? q4[k] : q4[k + 2]; const float r = __shfl_xor(snd, 8); q2[k] = (b8 ? q4[k + 2] : q4[k]) + r; }
                float mine; { const float snd = b4 ? q2[0] : q2[1]; const float r = __shfl_xor(snd, 4); mine = (b4 ? q2[1] : q2[0]) + r; }
                mine += __shfl_xor(mine, 2); mine += __shfl_xor(mine, 1);
                const int jj = (b32 ? 8 : 0) + (b16 ? 4 : 0) + (b8 ? 2 : 0) + (b4 ? 1 : 0);
                if ((lane & 3) == 0) {
                    if (jj < 8) { const float x = mine + dt_bias[jj]; const float y = __expf(x); const float sp = x > 20.f ? x : (y < 1e-3f ? y * (1.0f - 0.5f * y) : __logf(1.0f + y)); G[(size_t)row * 8 + jj] = -__expf(a_log[jj]) * sp; }
                    else BETA[(size_t)row * 8 + jj - 8] = sigm_f(mine);
                }
            }
        }
    }
}

__device__ __forceinline__ void conv_phase(const bf16_t* RAW0, bf16_t* dstQ, bf16_t* dstK, bf16_t* dstV, int gi_lo, int gi_n, const float* wconv, const float* gbuf, float* gconv_p, float* gconv_s) {
    const int tid = threadIdx.x, lane = tid & 63, w = tid >> 6, r4 = lane >> 4, col = (lane & 15) * 8;
    const int nitems = NCH * gi_n;
    for (int it = blockIdx.x * 8 + w; it < nitems; it += gridDim.x * 8) {
        const int c = it / gi_n, gi = gi_lo + it % gi_n, which = gi >> 3, hd = gi & 7;
        const bf16_t* raw = RAW0 + (size_t)which * SLOT_E + hd * 128 + col;
        bf16_t* dst = (which == 0 ? dstQ : (which == 1 ? dstK : dstV)) + ((size_t)(c * 8 + hd) * 64) * 128 + col;
        int t0, sb; bool last;
        if (c < 1024) { t0 = (c & 127) * 64; sb = -1; last = (c & 127) == 127; } else { t0 = 0; sb = c - 1024; last = true; }
        const int l0 = r4 * 16;
        u32x4 rw[19];
#pragma unroll
        for (int jj = 0; jj < 19; ++jj) { long rg = (long)c * 64 + l0 - 3 + jj; rg = rg < 0 ? 0 : rg; rw[jj] = __builtin_nontemporal_load((const u32x4*)(raw + (size_t)rg * 1024)); }
        float wv[4][8];
#pragma unroll
        for (int i = 0; i < 4; ++i) { const f32x4 a = *(const f32x4*)(wconv + i * 3072 + gi * 128 + col), b = *(const f32x4*)(wconv + i * 3072 + gi * 128 + col + 4);
            wv[i][0] = a[0]; wv[i][1] = a[1]; wv[i][2] = a[2]; wv[i][3] = a[3]; wv[i][4] = b[0]; wv[i][5] = b[1]; wv[i][6] = b[2]; wv[i][7] = b[3]; }
        if (t0 == 0 && r4 == 0) {
#pragma unroll
            for (int jj = 0; jj < 3; ++jj) {
                u32x4 hv = {0u, 0u, 0u, 0u};
                if (sb >= 0) { const float* bp = gbuf + ((size_t)sb * 3 + jj) * 3072 + gi * 128 + col; const f32x4 a = *(const f32x4*)bp, b = *(const f32x4*)(bp + 4);
                    hv.x = pk2(a[0], a[1]); hv.y = pk2(a[2], a[3]); hv.z = pk2(b[0], b[1]); hv.w = pk2(b[2], b[3]); }
                rw[jj] = hv;
            }
        }
#pragma unroll
        for (int p = 0; p < 16; ++p) {
            const int l = l0 + p; float acc[8];
#pragma unroll
            for (int e = 0; e < 8; ++e) acc[e] = 0.f;
            { f32x2v a01 = {0.f, 0.f}, a23 = {0.f, 0.f}, a45 = {0.f, 0.f}, a67 = {0.f, 0.f};
#pragma unroll
              for (int i = 0; i < 4; ++i) { const u32x4 pv = rw[p + i];
                  a01 += (f32x2v){wv[i][0], wv[i][1]} * (f32x2v){bflo(pv.x), bfhi(pv.x)}; a23 += (f32x2v){wv[i][2], wv[i][3]} * (f32x2v){bflo(pv.y), bfhi(pv.y)};
                  a45 += (f32x2v){wv[i][4], wv[i][5]} * (f32x2v){bflo(pv.z), bfhi(pv.z)}; a67 += (f32x2v){wv[i][6], wv[i][7]} * (f32x2v){bflo(pv.w), bfhi(pv.w)}; }
              acc[0] = a01[0]; acc[1] = a01[1]; acc[2] = a23[0]; acc[3] = a23[1]; acc[4] = a45[0]; acc[5] = a45[1]; acc[6] = a67[0]; acc[7] = a67[1]; }
            float y[8];
#pragma unroll
            for (int e = 0; e < 8; ++e) y[e] = silu_f(acc[e]);
            if (which < 2) {
                float ss = 0.f;
#pragma unroll
                for (int e = 0; e < 8; ++e) ss += y[e] * y[e];
                ss += __shfl_xor(ss, 1); ss += __shfl_xor(ss, 2); ss += __shfl_xor(ss, 4); ss += __shfl_xor(ss, 8);
                const float r = rsqrtf(ss + 1e-6f) * (which == 0 ? 0.08838834764831845f : 1.0f);
#pragma unroll
                for (int e = 0; e < 8; ++e) y[e] *= r;
            }
            u32x4 ov; ov.x = pk2(y[0], y[1]); ov.y = pk2(y[2], y[3]); ov.z = pk2(y[4], y[5]); ov.w = pk2(y[6], y[7]);
            *(u32x4*)(dst + (size_t)l * 128) = ov;
            if (last && l >= 61) {
                const u32x4 pv = rw[p + 3];
                float* o = (sb < 0 ? gconv_p + ((size_t)(c >> 7) * 3 + (l - 61)) * 3072 : gconv_s + ((size_t)sb * 3 + (l - 61)) * 3072) + gi * 128 + col;
                *(f32x4*)o = (f32x4){bflo(pv.x), bfhi(pv.x), bflo(pv.y), bfhi(pv.y)}; *(f32x4*)(o + 4) = (f32x4){bflo(pv.z), bfhi(pv.z), bflo(pv.w), bfhi(pv.w)};
            }
        }
    }
}

__device__ __forceinline__ void og_phase(bf16_t* ZG, const bf16_t* Ob, const float* SSQ, const float* gnorm, const bf16_t* P, float* sc_p, float* sc_s) {
    const int tid = threadIdx.x, lane = tid & 63, w = tid >> 6, r4 = lane >> 4, col = (lane & 15) * 8;
    const f32x4 g0 = *(const f32x4*)(gnorm + col), g1 = *(const f32x4*)(gnorm + col + 4);
    for (int idx = blockIdx.x * 512 + tid; idx < 24 * 2048; idx += gridDim.x * 512) {
        const int seq = idx >> 11, r = (idx >> 10) & 1, cl = idx & 1023;
        const int row = seq < 8 ? seq * 8192 + 8190 + r : NPROMPT + (seq - 8) * 64 + 62 + r;
        float* dst = seq < 8 ? sc_p + (size_t)(seq * 2 + r) * 1024 + cl : sc_s + (size_t)((seq - 8) * 2 + r) * 1024 + cl;
        *dst = bf2f(P[(size_t)row * 1024 + cl]);
    }
    const int nitems = M_TOK * 8 / 4;
    for (int it = blockIdx.x * 8 + w; it < nitems; it += gridDim.x * 8) {
        const int head = it & 7, row = (it >> 3) * 4 + r4;
        const u32x4 ov = *(const u32x4*)(Ob + ((size_t)((row >> 6) * 8 + head) * 64) * 128 + (col >> 5) * 2048 + (row & 63) * 32 + (col & 31));
        const u32x4 zv = *(const u32x4*)(ZG + (size_t)row * 1024 + head * 128 + col);
        float ss = (bflo(ov.x) * bflo(ov.x) + bfhi(ov.x) * bfhi(ov.x)) + (bflo(ov.y) * bflo(ov.y) + bfhi(ov.y) * bfhi(ov.y)) + (bflo(ov.z) * bflo(ov.z) + bfhi(ov.z) * bfhi(ov.z)) + (bflo(ov.w) * bflo(ov.w) + bfhi(ov.w) * bfhi(ov.w));
        ss += __shfl_xor(ss, 1); ss += __shfl_xor(ss, 2); ss += __shfl_xor(ss, 4); ss += __shfl_xor(ss, 8);
        const float rs = rsqrtf(ss * (1.0f / 128.0f) + 1e-6f);
        u32x4 wv;
        wv.x = pk2(bflo(ov.x) * rs * g0[0] * bflo(zv.x), bfhi(ov.x) * rs * g0[1] * bfhi(zv.x));
        wv.y = pk2(bflo(ov.y) * rs * g0[2] * bflo(zv.y), bfhi(ov.y) * rs * g0[3] * bfhi(zv.y));
        wv.z = pk2(bflo(ov.z) * rs * g1[0] * bflo(zv.z), bfhi(ov.z) * rs * g1[1] * bfhi(zv.z));
        wv.w = pk2(bflo(ov.w) * rs * g1[2] * bflo(zv.w), bfhi(ov.w) * rs * g1[3] * bfhi(zv.w));
        *(u32x4*)(ZG + (size_t)row * 1024 + head * 128 + col) = wv;
    }
}

__device__ __forceinline__ void chunk_phase(LAS unsigned char* lds, bf16_t* Qb, bf16_t* Kb, bf16_t* Vb, bf16_t* Wb, bf16_t* QKM, const float* G, const float* BETA, float* GC) {
    const int tid = threadIdx.x, half = tid >> 8, ht = tid & 255, lane = tid & 63, hw = (tid >> 6) & 3, fr = lane & 15, fq = lane >> 4;
    LAS unsigned char* base = lds + half * 71680;
    LAS bf16_t* sQ = (LAS bf16_t*)base; LAS bf16_t* sK = (LAS bf16_t*)(base + 17408); LAS bf16_t* sV = (LAS bf16_t*)(base + 34816);
    LAS float* sAt = (LAS float*)(base + 52224);
    LAS float* sgc = (LAS float*)(base + 69632); LAS float* sb1 = sgc + 64; LAS float* sb2 = sgc + 128;
    const int npair = NCH * 4;
    u32x4 fq_[4], fk_[4];
#define CH_PREF(prr) do { const int it_ = (prr) * 2 + half; const size_t tb_ = ((size_t)((it_ >> 3) * 8 + (it_ & 7)) * 64) * 128; \
        _Pragma("unroll") for (int i = 0; i < 4; ++i) { const int ch = ht + 256 * i; fq_[i] = __builtin_nontemporal_load((const u32x4*)(Qb + tb_ + ch * 8)); fk_[i] = __builtin_nontemporal_load((const u32x4*)(Kb + tb_ + ch * 8)); } } while (0)
    if ((int)blockIdx.x < npair) CH_PREF(blockIdx.x);
    for (int pr = blockIdx.x; pr < npair; pr += gridDim.x) {
        const int it = pr * 2 + half, c = it >> 3, h = it & 7;
        const size_t tb = ((size_t)(c * 8 + h) * 64) * 128;
#pragma unroll
        for (int i = 0; i < 4; ++i) { const int ch = ht + 256 * i, row = ch >> 4, c16 = ch & 15;
            *(LAS u32x4*)(sQ + row * 136 + c16 * 8) = fq_[i];
            *(LAS u32x4*)(sK + row * 136 + c16 * 8) = fk_[i];
            *(LAS u32x4*)(sV + row * 136 + c16 * 8) = __builtin_nontemporal_load((const u32x4*)(Vb + tb + ch * 8)); }
        if (hw == 0) {
            const float g = G[(size_t)(c * 64 + lane) * 8 + h], b = BETA[(size_t)(c * 64 + lane) * 8 + h];
            float s = g;
#pragma unroll
            for (int o = 1; o < 64; o <<= 1) { const float t = __shfl_up(s, o); if (lane >= o) s += t; }
            sgc[lane] = s; sb1[lane] = b; sb2[lane] = b * __expf(s); GC[(size_t)(c * 8 + h) * 64 + lane] = s;
        }
        __syncthreads();
        if (pr + (int)gridDim.x < npair) CH_PREF(pr + gridDim.x);
        {
            const int lt = hw;
            bf16x8 ak[4], aq[4];
#pragma unroll
            for (int kk = 0; kk < 4; ++kk) { ak[kk] = *(const LAS bf16x8*)(sK + (lt * 16 + fr) * 136 + kk * 32 + fq * 8); aq[kk] = *(const LAS bf16x8*)(sQ + (lt * 16 + fr) * 136 + kk * 32 + fq * 8); }
#pragma unroll
            for (int mt = 0; mt < 4; ++mt) {
                bf16x8 bk[4];
#pragma unroll
                for (int kk = 0; kk < 4; ++kk) bk[kk] = *(const LAS bf16x8*)(sK + (mt * 16 + fr) * 136 + kk * 32 + fq * 8);
                f32x4 dq = {0.f, 0.f, 0.f, 0.f};
#pragma unroll
                for (int kk = 0; kk < 4; ++kk) dq = mfma16(bk[kk], aq[kk], dq);
                { const int l = lt * 16 + fr; const float gl = sgc[l]; float o[4];
#pragma unroll
                  for (int r = 0; r < 4; ++r) { const int m = mt * 16 + fq * 4 + r; o[r] = (l >= m) ? dq[r] * __expf(gl - sgc[m]) : 0.f; }
                  u32x2 wv; wv.x = pk2(o[0], o[1]); wv.y = pk2(o[2], o[3]);
                  *(u32x2*)(QKM + ((size_t)(c * 8 + h) * 64 + l) * 64 + mt * 16 + fq * 4) = wv; }
                if (mt <= lt) {
                    f32x4 dk = {0.f, 0.f, 0.f, 0.f};
#pragma unroll
                    for (int kk = 0; kk < 4; ++kk) dk = mfma16(ak[kk], bk[kk], dk);
                    const int m = mt * 16 + fr; const float gm = sgc[m]; f32x4 a;
#pragma unroll
                    for (int r = 0; r < 4; ++r) { const int l = lt * 16 + fq * 4 + r; a[r] = (l > m) ? sb1[l] * dk[r] * __expf(sgc[l] - gm) : 0.f; }
                    *(LAS f32x4*)(sAt + m * 68 + lt * 16 + fq * 4) = a;
                }
            }
        }
        __syncthreads();
        {
            float sol[64];
            if (ht < 128) {
#pragma unroll
                for (int l = 0; l < 64; ++l) sol[l] = bf2f(sV[l * 136 + ht]) * sb1[l];
            } else {
#pragma unroll
                for (int l = 0; l < 64; ++l) sol[l] = bf2f(sK[l * 136 + ht - 128]) * sb2[l];
            }
#pragma unroll
            for (int m = 0; m < 63; ++m) { const float x = sol[m];
#pragma unroll
                for (int q4 = (m + 1) >> 2; q4 < 16; ++q4) { const f32x4 a4 = *(const LAS f32x4*)(sAt + m * 68 + q4 * 4);
#pragma unroll
                    for (int e = 0; e < 4; ++e) { const int l = q4 * 4 + e; if (l > m) sol[l] -= a4[e] * x; } } }
            if (ht < 128) { bf16_t* dstp = Vb + tb + (ht >> 5) * 2048 + (ht & 31);
#pragma unroll
                for (int l = 0; l < 64; ++l) dstp[l * 32] = (bf16_t)(pk2(sol[l], sol[l]) & 0xffffu);
            } else { bf16_t* dstp = Wb + tb + (ht - 128);
#pragma unroll
                for (int l = 0; l < 64; ++l) dstp[l * 128] = (bf16_t)(pk2(sol[l], sol[l]) & 0xffffu);
            }
        }
        {
            const float gend = sgc[63];
#pragma unroll
            for (int i = 0; i < 4; ++i) { const int ch = ht + 256 * i, row = ch >> 4, c16 = ch & 15; const float gr = sgc[row]; const float eq = __expf(gr), ek = __expf(gend - gr);
                const u32x4 q = *(const LAS u32x4*)(sQ + row * 136 + c16 * 8), k = *(const LAS u32x4*)(sK + row * 136 + c16 * 8);
                u32x4 qo, ko;
                qo.x = pk2(bflo(q.x) * eq, bfhi(q.x) * eq); qo.y = pk2(bflo(q.y) * eq, bfhi(q.y) * eq); qo.z = pk2(bflo(q.z) * eq, bfhi(q.z) * eq); qo.w = pk2(bflo(q.w) * eq, bfhi(q.w) * eq);
                ko.x = pk2(bflo(k.x) * ek, bfhi(k.x) * ek); ko.y = pk2(bflo(k.y) * ek, bfhi(k.y) * ek); ko.z = pk2(bflo(k.z) * ek, bfhi(k.z) * ek); ko.w = pk2(bflo(k.w) * ek, bfhi(k.w) * ek);
                *(u32x4*)(Qb + tb + ch * 8) = qo; *(u32x4*)(Kb + tb + ch * 8) = ko; }
        }
        __syncthreads();
    }
}

#undef CH_PREF
__device__ __forceinline__ void scan_phase(LAS unsigned char* lds, const bf16_t* Wb, const bf16_t* Qb, const bf16_t* Kb, bf16_t* UOb, const bf16_t* QKM, const float* GC, float* SSQ,
                           const float* state_in, float* st_p, float* st_s) {
    const int tid = threadIdx.x, lane = tid & 63, w = tid >> 6, fr = lane & 15, fq = lane >> 4;
    LAS bf16_t* sW = (LAS bf16_t*)lds; LAS bf16_t* sQ = (LAS bf16_t*)(lds + 17408); LAS bf16_t* sK = (LAS bf16_t*)(lds + 34816);
    LAS bf16_t* sQK = (LAS bf16_t*)(lds + 52224); LAS bf16_t* sU = (LAS bf16_t*)(lds + 61440); LAS bf16_t* sSt = (LAS bf16_t*)(lds + 65536); LAS bf16_t* sUt = (LAS bf16_t*)(lds + 74240);
    const int kt = w, lt = w & 3, vtw = w >> 2;
    for (int j = blockIdx.x; j < 768; j += gridDim.x) {
        int h, slice, c0, nch; const float* Sin; float* Sout;
        if (j < 256) { const int xcd = j & 7, idx = j >> 3, stream = xcd * 8 + (idx >> 2), seq = stream >> 3; h = stream & 7; slice = idx & 3; c0 = seq * 128; nch = 128; Sin = nullptr; Sout = st_p + (size_t)(seq * 8 + h) * 16384; }
        else { const int q = j - 256, sb = q >> 5; h = (q >> 2) & 7; slice = q & 3; c0 = 1024 + sb; nch = 1; Sin = state_in + (size_t)(sb * 8 + h) * 16384; Sout = st_s + (size_t)(sb * 8 + h) * 16384; }
        f32x4 S[2];
#pragma unroll
        for (int vt = 0; vt < 2; ++vt) {
#pragma unroll
            for (int r = 0; r < 4; ++r) S[vt][r] = Sin ? Sin[(kt * 16 + fq * 4 + r) * 128 + slice * 32 + vt * 16 + fr] : 0.f;
            u32x2 wv; wv.x = pk2n(S[vt][0], S[vt][1]); wv.y = pk2n(S[vt][2], S[vt][3]);
            *(LAS u32x2*)(sSt + (vt * 16 + fr) * 136 + kt * 16 + fq * 4) = wv;
        }
        u32x4 pw[2], pq[2], pkk[2], pqk, pu = {0u, 0u, 0u, 0u}; float geg;
#define SC_PREF(cc) do { const size_t tb_ = ((size_t)((cc) * 8 + h) * 64) * 128; \
        _Pragma("unroll") for (int i_ = 0; i_ < 2; ++i_) { const int ch_ = tid + 512 * i_; pw[i_] = *(const u32x4*)(Wb + tb_ + ch_ * 8); pq[i_] = *(const u32x4*)(Qb + tb_ + ch_ * 8); pkk[i_] = *(const u32x4*)(Kb + tb_ + ch_ * 8); } \
        pqk = *(const u32x4*)(QKM + ((size_t)((cc) * 8 + h) * 64) * 64 + tid * 8); \
        if (tid < 256) pu = __builtin_nontemporal_load((const u32x4*)(UOb + tb_ + slice * 2048 + (tid >> 2) * 32 + (tid & 3) * 8)); \
        geg = GC[(size_t)((cc) * 8 + h) * 64 + 63]; } while (0)
#define SC_PSTORE() do { _Pragma("unroll") for (int i_ = 0; i_ < 2; ++i_) { const int ch_ = tid + 512 * i_, row_ = ch_ >> 4, c16_ = ch_ & 15; \
            *(LAS u32x4*)(sW + row_ * 136 + c16_ * 8) = pw[i_]; *(LAS u32x4*)(sQ + row_ * 136 + c16_ * 8) = pq[i_]; *(LAS u32x4*)(sK + row_ * 136 + c16_ * 8) = pkk[i_]; } \
        *(LAS u32x4*)(sQK + (tid >> 3) * 72 + (tid & 7) * 8) = pqk; \
        if (tid < 256) *(LAS u32x4*)(sU + (tid >> 2) * 32 + (tid & 3) * 8) = pu; } while (0)
        SC_PREF(c0); SC_PSTORE(); float eg_cur = geg;
        __syncthreads();
        for (int ci = 0; ci < nch; ++ci) {
            const int c = c0 + ci;
            const float eg = __expf(eg_cur);
            if (ci + 1 < nch) SC_PREF(c + 1);
            {
                f32x4 d = {0.f, 0.f, 0.f, 0.f};
#pragma unroll
                for (int kk = 0; kk < 4; ++kk) d = mfma16(*(const LAS bf16x8*)(sW + (lt * 16 + fr) * 136 + kk * 32 + fq * 8), *(const LAS bf16x8*)(sSt + (vtw * 16 + fr) * 136 + kk * 32 + fq * 8), d);
                float u[4];
#pragma unroll
                for (int r = 0; r < 4; ++r) u[r] = bf2f(sU[(lt * 16 + fq * 4 + r) * 32 + vtw * 16 + fr]) - d[r];
                u32x2 wv; wv.x = pk2(u[0], u[1]); wv.y = pk2(u[2], u[3]);
                *(LAS u32x2*)(sUt + (vtw * 16 + fr) * 72 + lt * 16 + fq * 4) = wv;
            }
            __syncthreads();
            {
                f32x4 d = {0.f, 0.f, 0.f, 0.f};
#pragma unroll
                for (int kk = 0; kk < 4; ++kk) d = mfma16(*(const LAS bf16x8*)(sSt + (vtw * 16 + fr) * 136 + kk * 32 + fq * 8), *(const LAS bf16x8*)(sQ + (lt * 16 + fr) * 136 + kk * 32 + fq * 8), d);
#pragma unroll
                for (int k2 = 0; k2 < 2; ++k2) d = mfma16(*(const LAS bf16x8*)(sUt + (vtw * 16 + fr) * 72 + k2 * 32 + fq * 8), *(const LAS bf16x8*)(sQK + (lt * 16 + fr) * 72 + k2 * 32 + fq * 8), d);
                const int l = lt * 16 + fr;
                u32x2 wv; wv.x = pk2n(d[0], d[1]); wv.y = pk2n(d[2], d[3]);
                *(u32x2*)(UOb + ((size_t)(c * 8 + h) * 64) * 128 + slice * 2048 + l * 32 + vtw * 16 + fq * 4) = wv;
                float s = d[0] * d[0] + d[1] * d[1] + d[2] * d[2] + d[3] * d[3];
                s += __shfl_xor(s, 16); s += __shfl_xor(s, 32);
                if (fq == 0) SSQ[((size_t)(c * 64 + l) * 8 + h) * 8 + slice * 2 + vtw] = s;
            }
            {
                S[0] *= eg; S[1] *= eg;
#pragma unroll
                for (int k2 = 0; k2 < 2; ++k2) {
                    bf16x8 a;
#pragma unroll
                    for (int e = 0; e < 8; ++e) a[e] = (short)sK[(k2 * 32 + fq * 8 + e) * 136 + kt * 16 + fr];
#pragma unroll
                    for (int vt = 0; vt < 2; ++vt) S[vt] = mfma16(a, *(const LAS bf16x8*)(sUt + (vt * 16 + fr) * 72 + k2 * 32 + fq * 8), S[vt]);
                }
            }
            __syncthreads();
#pragma unroll
            for (int vt = 0; vt < 2; ++vt) { u32x2 wv; wv.x = pk2n(S[vt][0], S[vt][1]); wv.y = pk2n(S[vt][2], S[vt][3]); *(LAS u32x2*)(sSt + (vt * 16 + fr) * 136 + kt * 16 + fq * 4) = wv; }
            if (ci + 1 < nch) { SC_PSTORE(); eg_cur = geg; }
            __syncthreads();
        }
#pragma unroll
        for (int vt = 0; vt < 2; ++vt)
#pragma unroll
            for (int r = 0; r < 4; ++r) Sout[(kt * 16 + fq * 4 + r) * 128 + slice * 32 + vt * 16 + fr] = S[vt][r];
        __syncthreads();
#undef SC_PREF
#undef SC_PSTORE
    }
}

__device__ __forceinline__ void attn_phase(LAS unsigned char* lds, const bf16_t* QX, const bf16_t* KX, const bf16_t* VXT, bf16_t* AO) {
    const int tid = threadIdx.x, lane = tid & 63, w = tid >> 6, fr = lane & 15, fq = lane >> 4;
    LAS bf16_t* sm = (LAS bf16_t*)lds;
    const int nitems = 1024 + 64;
    for (int it = blockIdx.x; it < nitems; it += gridDim.x) {
        int seq, hh, row0, nrows;
        if (it < 1024) { seq = it >> 7; hh = (it >> 5) & 3; row0 = seq * 8192 + (it & 31) * 256; nrows = 256; }
        else { const int q = it - 1024; seq = 8 + (q >> 2); hh = q & 3; row0 = NPROMPT + (q >> 2) * 64; nrows = 64; }
        const bool act = w * 32 < nrows;
#pragma unroll
        for (int i = 0; i < 16; ++i) { const int ch = tid + 512 * i, key = ch >> 5, c32 = ch & 31;
            *(LAS u32x4*)(sm + key * 264 + c32 * 8) = *(const u32x4*)(KX + ((size_t)(seq * 256 + key)) * 1024 + hh * 256 + c32 * 8); }
        const int rowa = row0 + w * 32 + fr;
        u32x4 pf[2][8];
#pragma unroll
        for (int rt = 0; rt < 2; ++rt)
#pragma unroll
            for (int T = 0; T < 8; ++T) pf[rt][T] = (u32x4){0u, 0u, 0u, 0u};
        __syncthreads();
        if (act) {
#pragma unroll
            for (int rt = 0; rt < 2; ++rt) {
                bf16x8 qf[8];
#pragma unroll
                for (int kk = 0; kk < 8; ++kk) qf[kk] = __builtin_nontemporal_load((const bf16x8*)(QX + (size_t)(rowa + rt * 16) * 1024 + hh * 256 + kk * 32 + fq * 8));
                f32x4 sc[16];
#pragma unroll
                for (int t = 0; t < 16; ++t) { f32x4 d = {0.f, 0.f, 0.f, 0.f};
#pragma unroll
                    for (int kk = 0; kk < 8; ++kk) d = mfma16(*(const LAS bf16x8*)(sm + (t * 16 + fr) * 264 + kk * 32 + fq * 8), qf[kk], d);
                    sc[t] = d; }
                float mx = -3.0e38f;
#pragma unroll
                for (int t = 0; t < 16; ++t)
#pragma unroll
                    for (int r = 0; r < 4; ++r) mx = fmaxf(mx, sc[t][r]);
                mx = fmaxf(mx, __shfl_xor(mx, 16)); mx = fmaxf(mx, __shfl_xor(mx, 32));
                float sum = 0.f;
#pragma unroll
                for (int t = 0; t < 16; ++t)
#pragma unroll
                    for (int r = 0; r < 4; ++r) { sc[t][r] = __expf(sc[t][r] - mx); sum += sc[t][r]; }
                sum += __shfl_xor(sum, 16); sum += __shfl_xor(sum, 32);
                const float inv = 1.0f / sum;
#pragma unroll
                for (int T = 0; T < 8; ++T) { pf[rt][T].x = pk2(sc[2 * T][0] * inv, sc[2 * T][1] * inv); pf[rt][T].y = pk2(sc[2 * T][2] * inv, sc[2 * T][3] * inv);
                    pf[rt][T].z = pk2(sc[2 * T + 1][0] * inv, sc[2 * T + 1][1] * inv); pf[rt][T].w = pk2(sc[2 * T + 1][2] * inv, sc[2 * T + 1][3] * inv); }
            }
        }
        __syncthreads();
#pragma unroll
        for (int i = 0; i < 16; ++i) { const int ch = tid + 512 * i, dim = ch >> 5, c32 = ch & 31;
            *(LAS u32x4*)(sm + dim * 264 + c32 * 8) = *(const u32x4*)(VXT + ((size_t)((seq * 4 + hh) * 256 + dim)) * 256 + c32 * 8); }
        __syncthreads();
        if (act) {
#pragma unroll
            for (int dt = 0; dt < 16; ++dt) { f32x4 d0 = {0.f, 0.f, 0.f, 0.f}, d1 = {0.f, 0.f, 0.f, 0.f};
#pragma unroll
                for (int T = 0; T < 8; ++T) { const u32x2 lo = *(const LAS u32x2*)(sm + (dt * 16 + fr) * 264 + T * 32 + fq * 4), hi = *(const LAS u32x2*)(sm + (dt * 16 + fr) * 264 + T * 32 + 16 + fq * 4);
                    const bf16x8 vf = as_bf((u32x4){lo.x, lo.y, hi.x, hi.y});
                    d0 = mfma16(vf, as_bf(pf[0][T]), d0); d1 = mfma16(vf, as_bf(pf[1][T]), d1); }
                u32x2 w0; w0.x = pk2n(d0[0], d0[1]); w0.y = pk2n(d0[2], d0[3]);
                u32x2 w1; w1.x = pk2n(d1[0], d1[1]); w1.y = pk2n(d1[2], d1[3]);
                *(u32x2*)(AO + (size_t)rowa * 1024 + hh * 256 + dt * 16 + fq * 4) = w0;
                *(u32x2*)(AO + (size_t)(rowa + 16) * 1024 + hh * 256 + dt * 16 + fq * 4) = w1; }
        }
        __syncthreads();
    }
}


#define XB_TMO      128
#define XB_XCNT(j)  (256  + 64 * (j))
#define XB_XSUB(j)  (1280 + 64 * (j))
#define XB_XGEN(j)  (2304 + 64 * (j))
#define XB_TOP      3328
#define XB_TOPGEN   3392
#define XCD_BAR_WORDS 3456
#define XB_SPIN_CAP (1u << 18)
__device__ __forceinline__ unsigned xb_ld(unsigned* p)              { return __hip_atomic_load(p, __ATOMIC_RELAXED, __HIP_MEMORY_SCOPE_AGENT); }
__device__ __forceinline__ unsigned xb_add(unsigned* p, unsigned v) { return __hip_atomic_fetch_add(p, v, __ATOMIC_RELAXED, __HIP_MEMORY_SCOPE_AGENT); }
__device__ __forceinline__ unsigned xb_xcc_id() { return (unsigned)__builtin_amdgcn_s_getreg((3 << 11) | 20) & 0xFu; }
#define XB_SPIN(cond, bar) do { unsigned _sp = 0; while (cond) { __builtin_amdgcn_s_sleep(1); \
    if ((++_sp & 255u) == 0u) { if (xb_ld(&(bar)[XB_TMO])) break; if (_sp > XB_SPIN_CAP) { atomicAdd(&(bar)[XB_TMO], 1u); break; } } } } while (0)
struct XcdBarrier { unsigned* bar; unsigned x; volatile LAS unsigned* st; };
__device__ __forceinline__ XcdBarrier xcd_barrier_post(unsigned* bar, volatile LAS unsigned* st) {
    XcdBarrier b; b.bar = bar; b.x = xb_xcc_id(); b.st = st;
    if (threadIdx.x == 0) (void)xb_add(&bar[XB_XCNT(b.x)], 1u);
    return b;
}
__device__ __forceinline__ void xcd_barrier_complete(unsigned* bar, unsigned x, unsigned& nloc, unsigned& nx) {
    const unsigned G = gridDim.x * gridDim.y * gridDim.z;
    unsigned sum, cnt, mine, sp = 0u;
    for (;;) {
        sum = 0u; cnt = 0u; mine = 0u;
#pragma unroll
        for (unsigned j = 0; j < 16; ++j) { const unsigned c = xb_ld(&bar[XB_XCNT(j)]); sum += c; cnt += (c > 0u) ? 1u : 0u; mine = (j == x) ? c : mine; }
        if (sum == G) break;
        __builtin_amdgcn_s_sleep(1);
        if ((++sp & 255u) == 0u) { if (xb_ld(&bar[XB_TMO])) break; if (sp > XB_SPIN_CAP) { atomicAdd(&bar[XB_TMO], 1u); break; } }
    }
    nloc = mine > 0u ? mine : 1u; nx = cnt > 0u ? cnt : 1u;
}
__device__ __forceinline__ void xcd_barrier(const XcdBarrier& b) {
    asm volatile("s_waitcnt vmcnt(0)" ::: "memory");
    __syncthreads();
    if (threadIdx.x == 0) {
        unsigned* bar = b.bar;
        __builtin_amdgcn_s_waitcnt(0);
        unsigned nloc = b.st[0], nx = b.st[1];
        if (nloc == 0u) { xcd_barrier_complete(bar, b.x, nloc, nx); b.st[0] = nloc; b.st[1] = nx; }
        const unsigned old = xb_add(&bar[XB_XSUB(b.x)], 1u);
        const unsigned gen = old / nloc;
        if (old + 1u == (gen + 1u) * nloc) {
            __builtin_amdgcn_fence(__ATOMIC_RELEASE, "agent");
            asm volatile("s_waitcnt vmcnt(0)" ::: "memory");
            const unsigned og = xb_add(&bar[XB_TOP], 1u);
            const unsigned tg = og / nx;
            if (og + 1u == (tg + 1u) * nx) xb_add(&bar[XB_TOPGEN], 1u);
            else XB_SPIN(xb_ld(&bar[XB_TOPGEN]) == tg, bar);
            __builtin_amdgcn_fence(__ATOMIC_ACQUIRE, "agent");
            xb_add(&bar[XB_XGEN(b.x)], 1u);
            asm volatile("s_waitcnt vmcnt(0)" ::: "memory");
        } else {
            XB_SPIN(xb_ld(&bar[XB_XGEN(b.x)]) == gen, bar);
            __builtin_amdgcn_fence(__ATOMIC_ACQUIRE, "agent");
            asm volatile("s_waitcnt vmcnt(0)" ::: "memory");
        }
    }
    __syncthreads();
}

struct Args { const float* in[33]; float* out; unsigned char* ws; int ph_lo, ph_hi; };

__global__ void __launch_bounds__(512, 2) fwd_kernel(Args a) {
    extern __shared__ __attribute__((aligned(16))) unsigned char lds_raw[];
    LAS unsigned char* lds = (LAS unsigned char*)lds_raw;
    cg::grid_group grid = cg::this_grid();
    const int lo = a.ph_lo, hi = a.ph_hi, G = gridDim.x, bid = blockIdx.x;
    unsigned char* const ws = a.ws;
    volatile LAS unsigned* bst = (volatile LAS unsigned*)(lds + (LDS_BYTES - 16));
    if (threadIdx.x == 0) { bst[0] = 0u; bst[1] = 0u; }
    __syncthreads();
    const XcdBarrier xbar = xcd_barrier_post((unsigned*)(ws + OFF_BAR), bst);
    if (hi < 0) grid.sync();
    using namespace pg8;
#define WBp ((bf16_t*)(ws + OFF_WB))
#define Gd ((float*)(ws + OFF_G))
#define BETAp ((float*)(ws + OFF_BETA))
#define GCp ((float*)(ws + OFF_GC))
#define SSQp ((float*)(ws + OFF_SSQ))
#define MHp ((bf16_t*)(ws + OFF_MH))
#define KXp ((bf16_t*)(ws + OFF_KX))
#define VXTp ((bf16_t*)(ws + OFF_VXT))
#define SL(i) ((bf16_t*)(ws + OFF_SLOTS + (size_t)(i) * SLOT_B))
#define Xp (a.out)
#define IN(k) (lo <= (k) && (k) < hi)
#define SEAM(k) do { if ((k) + 1 < hi) xcd_barrier(xbar); } while (0)
#define GEMM_RUN(PERMV, Aptr, Bptr, MM, NN, KK, EE) do { Gemm g_{(Aptr), (Bptr), (MM), (NN), (KK)}; StaticOrder so_; so_.init((MM), (NN), G, bid); gemm_phase<PERMV>(lds, g_, so_, (EE)); } while (0)
#define ROW_RUN(x0, x1, xb, T, gpost, sc, Xo, Xob, gpre, H, n, ab) rowpass(lds, (x0), (x1), (xb), (T), (gpost), (sc), (Xo), (Xob), (gpre), (H), (n), (ab), a.in[13], a.in[15], a.in[16], Gd, BETAp)

    if (IN(0)) {
        for (int jb = 0; jb < 32; ++jb) {
            const float* src = a.in[13]; int K = 1024, ld = 9232, N = 1024, mode = 0, coloff = 0, halfoff = 0; bf16_t* dst = WBp;
            switch (jb) {
            case 0: src = a.in[9]; ld = 5632; N = 5632; mode = 1; halfoff = 2816; dst = WBp + WB_F1A; break;
            case 1: src = a.in[10]; K = 2816; ld = 1024; dst = WBp + WB_F1B; break;
            case 2: N = 3072; dst = WBp + WB_QKV; break;
            case 3: coloff = 3072; dst = WBp + WB_MIX2; break;
            case 4: N = 2048; mode = 1; coloff = 5136; halfoff = 1024; dst = WBp + WB_MIX2 + (size_t)1024 * 1024; break;
            case 5: coloff = 7184; dst = WBp + WB_MIX2 + (size_t)3072 * 1024; break;
            case 6: coloff = 8208; dst = WBp + WB_MIX2 + (size_t)4096 * 1024; break;
            case 7: coloff = 4112; dst = WBp + WB_SB; break;
            case 8: src = a.in[18]; ld = 1024; dst = WBp + WB_GO; break;
            case 9: src = a.in[20]; ld = 1024; dst = WBp + WB_SCO; break;
            case 10: src = a.in[21]; ld = 1024; dst = WBp + WB_MO; break;
            case 11: src = a.in[25]; ld = 1024; dst = WBp + WB_XQ; break;
            case 12: src = a.in[26]; ld = 2048; N = 2048; dst = WBp + WB_XKV; break;
            case 13: src = a.in[27]; ld = 1024; dst = WBp + WB_XO; break;
            case 14: src = a.in[30]; ld = 5632; N = 5632; mode = 1; halfoff = 2816; dst = WBp + WB_F2A; break;
            case 15: src = a.in[31]; K = 2816; ld = 1024; dst = WBp + WB_F2B; break;
            default: { const int sb = jb - 16; src = a.in[4] + (size_t)sb * 262144; K = 256; ld = 1024; dst = VXTp + (size_t)(8 + sb) * 262144; } break;
            }
            cvt_job(lds, src, K, ld, N, mode, coloff, halfoff, dst);
        }
        {
            const float* ck = a.in[3]; bf16_t* dst = KXp + (size_t)8 * 262144;
            for (size_t i = (size_t)bid * 512 + threadIdx.x; i < (size_t)16 * 262144 / 4; i += (size_t)G * 512) { const f32x4 v = __builtin_nontemporal_load((const f32x4*)(ck + i * 4)); u32x2 wv; wv.x = pk2(v[0], v[1]); wv.y = pk2(v[2], v[3]); *(u32x2*)(dst + i * 4) = wv; }
        }
    }
    if (IN(1)) { ROW_RUN(a.in[0], a.in[1], (const bf16_t*)nullptr, (const bf16_t*)nullptr, nullptr, 0.f, (float*)nullptr, (bf16_t*)nullptr, a.in[8], SL(0), M_TOK, false); }
    if (IN(2)) { ROW_RUN(a.in[2], a.in[2], (const bf16_t*)nullptr, (const bf16_t*)nullptr, nullptr, 0.f, (float*)nullptr, (bf16_t*)nullptr, a.in[24], MHp, 2048, false); SEAM(2); }
    if (IN(3)) { EpiArgs E{}; E.mode = M_KV; E.fo0 = a.out + O_MK; E.fo1 = a.out + O_MV; E.o0 = KXp; E.o1 = VXTp; GEMM_RUN(false, MHp, WBp + WB_XKV, 2048, 2048, 1024, E); }
    if (IN(4)) { EpiArgs E{}; E.mode = M_SWIGLU; E.o0 = SL(1); GEMM_RUN(true, SL(0), WBp + WB_F1A, M_TOK, 5632, 1024, E); SEAM(4); }
    if (IN(5)) { EpiArgs E{}; E.mode = M_BF16; E.scale = 1.f; E.o0 = SL(4); GEMM_RUN(true, SL(1), WBp + WB_F1B, M_TOK, 1024, 2816, E); SEAM(5); }
    if (IN(6)) { ROW_RUN(a.in[0], a.in[1], (const bf16_t*)nullptr, (const bf16_t*)SL(4), a.in[11], 0.5f, (float*)nullptr, SL(6), a.in[12], SL(0), M_TOK, true); SEAM(6); }
    if (IN(7)) { EpiArgs E{}; E.mode = M_BF16; E.scale = 1.f; E.o0 = SL(1); GEMM_RUN(true, SL(0), WBp + WB_QKV, M_TOK, 3072, 1024, E); SEAM(7); }
    if (IN(8)) { conv_phase(SL(1), SL(4), SL(5), SL(1), 0, 16, a.in[14], a.in[6], a.out + O_GCP, a.out + O_GCS); SEAM(8); }
    if (IN(9)) { conv_phase(SL(1), SL(4), SL(5), SL(1), 16, 8, a.in[14], a.in[6], a.out + O_GCP, a.out + O_GCS); SEAM(9); }
    if (IN(10)) { chunk_phase(lds, SL(4), SL(5), SL(1), SL(2), SL(3), Gd, BETAp, GCp); SEAM(10); }
    if (IN(11)) { scan_phase(lds, SL(2), SL(4), SL(5), SL(1), SL(3), GCp, a.out  , a.in[5], a.out + O_GSP, a.out + O_GSS); SEAM(11); }
    if (IN(12)) {
        { EpiArgs E{}; E.mode = M_ZOG; E.o0 = SL(2); E.a0 = SL(1); E.f0 = (const float*)a.out; E.f1 = a.in[17]; GEMM_RUN(true, SL(0), WBp + WB_MIX2, M_TOK, 1024, 1024, E); }
        { EpiArgs E{}; E.mode = M_MIX2; E.o0 = SL(3); GEMM_RUN(true, SL(0), WBp + WB_MIX2 + (size_t)1024 * 1024, M_TOK, 2048, 1024, E); }
        { EpiArgs E{}; E.mode = M_BF16; E.scale = 1.f; E.act = 2; E.o0 = SL(4); GEMM_RUN(true, SL(0), WBp + WB_MIX2 + (size_t)3072 * 1024, M_TOK, 2048, 1024, E); }
        SEAM(12); }
    if (IN(13)) {
        for (int idx = bid * 512 + threadIdx.x; idx < 24 * 2048; idx += G * 512) {
            const int seq = idx >> 11, r = (idx >> 10) & 1, cl = idx & 1023;
            const int row = seq < 8 ? seq * 8192 + 8190 + r : NPROMPT + (seq - 8) * 64 + 62 + r;
            float* dst = seq < 8 ? a.out + O_SCP + (size_t)(seq * 2 + r) * 1024 + cl : a.out + O_SCS + (size_t)((seq - 8) * 2 + r) * 1024 + cl;
            *dst = bf2f(SL(3)[(size_t)row * 1024 + cl]);
        }
    }
    if (IN(14)) { EpiArgs E{}; E.mode = M_SB; E.o0 = SL(1); E.a0 = SL(3); E.f0 = a.in[19]; E.f1 = a.in[7]; GEMM_RUN(true, SL(0), WBp + WB_SB, M_TOK, 1024, 1024, E); SEAM(14); }
    if (IN(15)) { EpiArgs E{}; E.mode = M_GDNOUT; E.o0 = SL(4); GEMM_RUN(true, SL(2), WBp + WB_GO, M_TOK, 1024, 1024, E); SEAM(15); }
    if (IN(16)) { EpiArgs E{}; E.mode = M_SCOUT; E.o0 = SL(4); E.a0 = SL(5); GEMM_RUN(true, SL(1), WBp + WB_SCO, M_TOK, 1024, 1024, E); SEAM(16); }
    if (IN(17)) { EpiArgs E{}; E.mode = M_BF16; E.scale = 1.f; E.o0 = SL(2); GEMM_RUN(true, SL(4), WBp + WB_MO, M_TOK, 1024, 1024, E); SEAM(17); }
    if (IN(18)) { ROW_RUN(a.in[0], a.in[1], (const bf16_t*)SL(6), (const bf16_t*)SL(2), a.in[22], 1.0f, (float*)nullptr, SL(6), a.in[23], SL(0), M_TOK, false); SEAM(18); }
    if (IN(19)) { EpiArgs E{}; E.mode = M_BF16; E.scale = 0.0625f; E.o0 = SL(1); GEMM_RUN(true, SL(0), WBp + WB_XQ, M_TOK, 1024, 1024, E); SEAM(19); }
    if (IN(20)) { attn_phase(lds, SL(1), KXp, VXTp, SL(4)); SEAM(20); }
    if (IN(21)) { EpiArgs E{}; E.mode = M_BF16; E.scale = 1.f; E.o0 = SL(2); GEMM_RUN(true, SL(4), WBp + WB_XO, M_TOK, 1024, 1024, E); SEAM(21); }
    if (IN(22)) { ROW_RUN(a.in[0], a.in[1], (const bf16_t*)SL(6), (const bf16_t*)SL(2), a.in[28], 1.0f, (float*)nullptr, SL(6), a.in[29], SL(0), M_TOK, false); SEAM(22); }
    if (IN(23)) { EpiArgs E{}; E.mode = M_SWIGLU; E.o0 = SL(1); GEMM_RUN(true, SL(0), WBp + WB_F2A, M_TOK, 5632, 1024, E); SEAM(23); }
    if (IN(24)) { EpiArgs E{}; E.mode = M_BF16; E.scale = 1.f; E.o0 = SL(4); GEMM_RUN(true, SL(1), WBp + WB_F2B, M_TOK, 1024, 2816, E); SEAM(24); }
    if (IN(25)) { ROW_RUN(a.in[0], a.in[1], (const bf16_t*)SL(6), (const bf16_t*)SL(4), a.in[32], 0.5f, Xp, (bf16_t*)nullptr, (const float*)nullptr, (bf16_t*)nullptr, M_TOK, false); }
}


#ifdef MK_DUMP_OFF
__global__ void dump_kernel(const unsigned* __restrict__ srcw, unsigned* __restrict__ dst, size_t n) {
    for (size_t i = (size_t)blockIdx.x * blockDim.x + threadIdx.x; i < n; i += (size_t)gridDim.x * blockDim.x) { unsigned v = srcw[i]; if ((v & 0x7f800000u) == 0x7f800000u) v &= 0x3fffffffu; dst[i] = v; }
}
#endif
extern "C" void kernel_launch(void* const* d_in, const int* in_sizes, int n_in, void* d_out, int out_size, void* d_ws, size_t ws_size, hipStream_t stream) {
    static int grid = 0;
    if (grid == 0) {
        if (n_in != 33 || ws_size < WS_END) { fprintf(stderr, "kernel_launch: unexpected n_in %d / ws_size %zu (need %zu)\n", n_in, ws_size, (size_t)WS_END); grid = -1; return; }
        int dev = 0, cus = 0, per_cu = 0;
        (void)hipGetDevice(&dev); (void)hipDeviceGetAttribute(&cus, hipDeviceAttributeMultiprocessorCount, dev);
        if (hipFuncSetAttribute((const void*)fwd_kernel, hipFuncAttributeMaxDynamicSharedMemorySize, LDS_BYTES) != hipSuccess) { fprintf(stderr, "kernel_launch: hipFuncSetAttribute failed\n"); grid = -1; return; }
        if (hipOccupancyMaxActiveBlocksPerMultiprocessor(&per_cu, (const void*)fwd_kernel, 512, LDS_BYTES) != hipSuccess || per_cu < 1) { fprintf(stderr, "kernel_launch: occupancy query says %d\n", per_cu); per_cu = 1; }
        (void)hipGetLastError();
        grid = cus * 1;
        if (grid <= 0) grid = 256;
    }
    if (grid < 0) return;
    Args a{};
    for (int i = 0; i < 33; ++i) a.in[i] = (const float*)d_in[i];
    a.out = (float*)d_out; a.ws = (unsigned char*)d_ws;
    (void)hipMemsetAsync((unsigned char*)d_ws + OFF_BAR, 0, 16384, stream);
#if MK_SINGLE
    a.ph_lo = 0; a.ph_hi = (MK_PLIMIT < NPHASE ? MK_PLIMIT : NPHASE);
    void* args[] = {&a};
    hipError_t e = hipLaunchCooperativeKernel((const void*)fwd_kernel, dim3(grid), dim3(512), args, LDS_BYTES, stream);
    if (e != hipSuccess) fprintf(stderr, "cooperative launch failed: %s (grid %d)\n", hipGetErrorString(e), grid);
#else
    for (int p = 0; p < (MK_PLIMIT < NPHASE ? MK_PLIMIT : NPHASE); ++p) {
        a.ph_lo = p; a.ph_hi = p + 1;
        hipLaunchKernelGGL(fwd_kernel, dim3(grid), dim3(512), LDS_BYTES, stream, a);
    }
#endif
#ifdef MK_DUMP_OFF
    hipLaunchKernelGGL(dump_kernel, dim3(2048), dim3(256), 0, stream, (const unsigned*)((const unsigned char*)d_ws + (size_t)(MK_DUMP_OFF)), (unsigned*)d_out, (size_t)(MK_DUMP_N));
#endif
}
```

```cpp
#include <hip/hip_runtime.h>
#include <hip/hip_cooperative_groups.h>
#include <cstdio>
namespace cg = cooperative_groups;

#ifndef MK_SINGLE
#define MK_SINGLE 1
#endif
#ifndef MK_PLIMIT
#define MK_PLIMIT 99

#endif

#define LAS __attribute__((address_space(3)))
typedef unsigned short bf16_t;
typedef short bf16x8 __attribute__((ext_vector_type(8)));
typedef float f32x4 __attribute__((ext_vector_type(4)));
typedef unsigned u32x4 __attribute__((ext_vector_type(4)));
typedef unsigned u32x2 __attribute__((ext_vector_type(2)));

constexpr int M_TOK = 66560, NCH = 1040, NPROMPT = 65536;
constexpr size_t SLOT_E = (size_t)M_TOK * 1024;
constexpr size_t SLOT_B = SLOT_E * 2;
constexpr int LDS_BYTES = 147456;
constexpr int NPHASE = 26;

constexpr size_t WB_F1A = 0, WB_F1B = 5767168, WB_QKV = 8650752, WB_MIX2 = 11796480, WB_SB = 17039360, WB_GO = 18087936,
                 WB_SCO = 19136512, WB_MO = 20185088, WB_XQ = 21233664, WB_XKV = 22282240, WB_XO = 24379392, WB_F2A = 25427968, WB_F2B = 31195136;
constexpr size_t OFF_WB = 0, OFF_G = 68157440, OFF_BETA = 70287360, OFF_GC = 72417280, OFF_SSQ = 74547200  , OFF_MH = 74547200,
                 OFF_KX = 78741504, OFF_VXT = 91324416, OFF_SLOTS = 103907328, OFF_BAR = OFF_SLOTS + 7 * SLOT_B, WS_END = OFF_BAR + 16384;
constexpr size_t O_GSP = 68157440, O_GCP = 69206016, O_SCP = 69279744, O_MK = 69296128, O_MV = 71393280, O_GSS = 73490432, O_GCS = 75587584, O_SCS = 75735040;

typedef float f32x2v __attribute__((ext_vector_type(2)));
typedef __bf16 bf16x2v __attribute__((ext_vector_type(2)));
__device__ __forceinline__ unsigned pk2n(float lo, float hi) { const f32x2v v = {lo, hi}; const bf16x2v b = __builtin_convertvector(v, bf16x2v); return __builtin_bit_cast(unsigned, b); }
__device__ __forceinline__ unsigned pk2(float lo, float hi) { unsigned r; asm volatile("s_nop 1\n\tv_cvt_pk_bf16_f32 %0, %1, %2" : "=v"(r) : "v"(lo), "v"(hi)); return r; }
__device__ __forceinline__ float bf2f(bf16_t h) { return __uint_as_float((unsigned)h << 16); }
__device__ __forceinline__ float bflo(unsigned w) { return __uint_as_float(w << 16); }
__device__ __forceinline__ float bfhi(unsigned w) { return __uint_as_float(w & 0xffff0000u); }
__device__ __forceinline__ float silu_f(float x) { return x * __builtin_amdgcn_rcpf(1.f + __expf(-x)); }
__device__ __forceinline__ float sigm_f(float x) { return __builtin_amdgcn_rcpf(1.f + __expf(-x)); }
__device__ __forceinline__ f32x4 mfma16(bf16x8 a, bf16x8 b, f32x4 c) { return __builtin_amdgcn_mfma_f32_16x16x32_bf16(a, b, c, 0, 0, 0); }
__device__ __forceinline__ bf16x8 as_bf(u32x4 v) { return __builtin_bit_cast(bf16x8, v); }
__device__ __forceinline__ void seq_of_row(int row, int& sb, int& t, int& T, int& sidx) {
    if (row < NPROMPT) { sb = -1; sidx = row >> 13; t = row & 8191; T = 8192; } else { const int q = row - NPROMPT; sb = q >> 6; sidx = sb; t = q & 63; T = 64; }
}

namespace pg8 {
constexpr int BM = 256, BK = 64, HALF = 128, HTB = HALF * BK * 2, STAGE_BYTES = 8 * HTB, NXCD = 8, WGM = 8;
__host__ __device__ __forceinline__ int lds_byte(int r, int c) { const int st = (r >> 4) * 2 + (c >> 5), rr = r & 15, cc = c & 31, ob = rr * 64 + cc * 2; return st * 1024 + (ob ^ (((ob >> 9) & 1) << 5)); }
__host__ __device__ __forceinline__ void stage_rc(int b, int& R, int& C) { const int st = b / 1024, sb = b % 1024, swz = sb ^ (((sb >> 9) & 1) << 5); R = (st >> 1) * 16 + swz / 64; C = (st & 1) * 32 + (swz % 64) / 2; }
__host__ __device__ __forceinline__ int perm32(int rho) { const int n = rho >> 4, i = rho & 15; return 8 * (i >> 2) + 4 * n + (i & 3); }
struct Unit { int pm, pn; };
struct Gemm { const bf16_t* A; const bf16_t* Bt; int M, N, K; };
struct StaticOrder {
    int nM, nN, nwg, G, c;
    __device__ void init(int M, int N, int G_, int c_) { nM = M / BM; nN = N / BM; nwg = nM * nN; G = G_; c = c_; }
    __device__ bool next(int i, Unit& u) const {
        const long L = (long)i * G + c; if (L >= nwg) return false;
        int wgid = (int)L; { const int q = nwg / NXCD, r = nwg % NXCD, xcd = wgid % NXCD, off = wgid / NXCD; wgid = (xcd < r ? xcd * (q + 1) : r * (q + 1) + (xcd - r) * q) + off; }
        const int nig = WGM * nN, gid = wgid / nig, fm = gid * WGM, gsz = (nM - fm) < WGM ? (nM - fm) : WGM;
        u.pm = fm + ((wgid % nig) % gsz); u.pn = (wgid % nig) / gsz; return true;
    }
};

enum { M_SWIGLU = 0, M_BF16 = 1, M_MIX2 = 2, M_SB = 3, M_GDNOUT = 4, M_SCOUT = 5, M_F32 = 6, M_KV = 7, M_ZOG = 8 };
struct EpiArgs {
    int mode; float scale; int act;
    bf16_t* o0; bf16_t* o1; bf16_t* o2; bf16_t* o3;
    const bf16_t* a0;
    const float* f0; const float* f1;
    float* fo0; float* fo1;
};

__device__ __forceinline__ void epi_perm(const EpiArgs E, const f32x4 (&acc)[2][2][4][2], const Unit& u, int wr, int wc, int fr, int fq) {
    const int row0 = u.pm * BM + wr * 64 + fr, c8 = wc * 32 + 8 * fq;
    if (E.mode == M_SWIGLU) {
#pragma unroll
        for (int ai = 0; ai < 2; ++ai)
#pragma unroll
            for (int m = 0; m < 4; ++m) {
                const int row = row0 + ai * HALF + m * 16; float o[8];
#pragma unroll
                for (int n = 0; n < 2; ++n)
#pragma unroll
                    for (int j = 0; j < 4; ++j) o[n * 4 + j] = silu_f(acc[ai][0][m][n][j]) * acc[ai][1][m][n][j];
                u32x4 w; w.x = pk2(o[0], o[1]); w.y = pk2(o[2], o[3]); w.z = pk2(o[4], o[5]); w.w = pk2(o[6], o[7]);
                *(u32x4*)(E.o0 + (size_t)row * 2816 + u.pn * 128 + c8) = w;
            }
    } else if (E.mode == M_BF16) {
        bf16_t* base = E.o0 + (size_t)(u.pn >> 2) * SLOT_E; const int colt = (u.pn & 3) * 256; const float s = E.scale;
#pragma unroll
        for (int ai = 0; ai < 2; ++ai)
#pragma unroll
            for (int m = 0; m < 4; ++m) {
                const int row = row0 + ai * HALF + m * 16;
#pragma unroll
                for (int bj = 0; bj < 2; ++bj) {
                    f32x4 v0 = acc[ai][bj][m][0] * s, v1 = acc[ai][bj][m][1] * s;
                    if (E.act == 1) {
#pragma unroll
                        for (int j = 0; j < 4; ++j) { v0[j] = silu_f(v0[j]); v1[j] = silu_f(v1[j]); } }
                    if (E.act == 2) {
#pragma unroll
                        for (int j = 0; j < 4; ++j) { v0[j] = sigm_f(v0[j]); v1[j] = sigm_f(v1[j]); } }
                    u32x4 w; w.x = pk2(v0[0], v0[1]); w.y = pk2(v0[2], v0[3]); w.z = pk2(v1[0], v1[1]); w.w = pk2(v1[2], v1[3]);
                    *(u32x4*)(base + (size_t)row * 1024 + colt + bj * HALF + c8) = w;
                }
            }
    } else if (E.mode == M_MIX2) {
        const int cc = u.pn * 128 + c8;
#pragma unroll
        for (int ai = 0; ai < 2; ++ai)
#pragma unroll
            for (int m = 0; m < 4; ++m) {
                const int row = row0 + ai * HALF + m * 16; float o[8];
#pragma unroll
                for (int n = 0; n < 2; ++n)
#pragma unroll
                    for (int j = 0; j < 4; ++j) o[n * 4 + j] = acc[ai][0][m][n][j] * acc[ai][1][m][n][j];
                u32x4 w; w.x = pk2(o[0], o[1]); w.y = pk2(o[2], o[3]); w.z = pk2(o[4], o[5]); w.w = pk2(o[6], o[7]);
                *(u32x4*)(E.o0 + (size_t)row * 1024 + cc) = w;
            }
    } else if (E.mode == M_ZOG) {
#pragma unroll
        for (int bj = 0; bj < 2; ++bj) {
            const int head = u.pn * 2 + bj;
            const f32x4 g0 = *(const f32x4*)(E.f1 + c8), g1 = *(const f32x4*)(E.f1 + c8 + 4);
#pragma unroll
            for (int ai = 0; ai < 2; ++ai)
#pragma unroll
                for (int m = 0; m < 4; ++m) {
                    const int row = row0 + ai * HALF + m * 16;
                    const u32x4 ov = __builtin_nontemporal_load((const u32x4*)(E.a0 + ((size_t)((row >> 6) * 8 + head) * 64) * 128 + (c8 >> 5) * 2048 + (row & 63) * 32 + (c8 & 31)));
                    const f32x4 s0 = *(const f32x4*)(E.f0 + ((size_t)row * 8 + head) * 8), s1 = *(const f32x4*)(E.f0 + ((size_t)row * 8 + head) * 8 + 4);
                    const float ss = (s0[0] + s0[1]) + (s0[2] + s0[3]) + (s1[0] + s1[1]) + (s1[2] + s1[3]);
                    const float rs = rsqrtf(ss * (1.0f / 128.0f) + 1e-6f);
                    const f32x4 z0 = acc[ai][bj][m][0], z1 = acc[ai][bj][m][1];
                    float o[8];
                    o[0] = bflo(ov.x) * rs * g0[0] * silu_f(z0[0]); o[1] = bfhi(ov.x) * rs * g0[1] * silu_f(z0[1]);
                    o[2] = bflo(ov.y) * rs * g0[2] * silu_f(z0[2]); o[3] = bfhi(ov.y) * rs * g0[3] * silu_f(z0[3]);
                    o[4] = bflo(ov.z) * rs * g1[0] * silu_f(z1[0]); o[5] = bfhi(ov.z) * rs * g1[1] * silu_f(z1[1]);
                    o[6] = bflo(ov.w) * rs * g1[2] * silu_f(z1[2]); o[7] = bfhi(ov.w) * rs * g1[3] * silu_f(z1[3]);
                    u32x4 w; w.x = pk2(o[0], o[1]); w.y = pk2(o[2], o[3]); w.z = pk2(o[4], o[5]); w.w = pk2(o[6], o[7]);
                    *(u32x4*)(E.o0 + (size_t)row * 1024 + head * 128 + c8) = w;
                }
        }
    } else if (E.mode == M_SB) {
#pragma unroll
        for (int bj = 0; bj < 2; ++bj) {
            const int col = u.pn * 256 + bj * HALF + c8;
            float wc3[3][8];
#pragma unroll
            for (int i = 0; i < 3; ++i) { const f32x4 a = *(const f32x4*)(E.f0 + i * 1024 + col), b = *(const f32x4*)(E.f0 + i * 1024 + col + 4);
                wc3[i][0] = a[0]; wc3[i][1] = a[1]; wc3[i][2] = a[2]; wc3[i][3] = a[3]; wc3[i][4] = b[0]; wc3[i][5] = b[1]; wc3[i][6] = b[2]; wc3[i][7] = b[3]; }
#pragma unroll
            for (int ai = 0; ai < 2; ++ai)
#pragma unroll
                for (int m = 0; m < 4; ++m) {
                    const int row = row0 + ai * HALF + m * 16;
                    int sb, t, T, sidx; seq_of_row(row, sb, t, T, sidx);
                    float uu[8];
#pragma unroll
                    for (int e = 0; e < 8; ++e) uu[e] = 0.f;
#pragma unroll
                    for (int i = 0; i < 3; ++i) {
                        const int tt = t - 2 + i; const bool inseq = tt >= 0; const bool usebuf = (!inseq) && (sb >= 0);
                        const int rowp = inseq ? (row - 2 + i) : row;
                        const int bidx = (sb >= 0 ? sb : 0) * 2 + (inseq ? 0 : tt + 2);
                        const u32x4 pv = *(const u32x4*)(E.a0 + (size_t)rowp * 1024 + col);
                        const float* bp = E.f1 + (size_t)bidx * 1024 + col; const f32x4 a = *(const f32x4*)bp, b = *(const f32x4*)(bp + 4);
                        float x[8];
                        x[0] = inseq ? bflo(pv.x) : (usebuf ? a[0] : 0.f); x[1] = inseq ? bfhi(pv.x) : (usebuf ? a[1] : 0.f);
                        x[2] = inseq ? bflo(pv.y) : (usebuf ? a[2] : 0.f); x[3] = inseq ? bfhi(pv.y) : (usebuf ? a[3] : 0.f);
                        x[4] = inseq ? bflo(pv.z) : (usebuf ? b[0] : 0.f); x[5] = inseq ? bfhi(pv.z) : (usebuf ? b[1] : 0.f);
                        x[6] = inseq ? bflo(pv.w) : (usebuf ? b[2] : 0.f); x[7] = inseq ? bfhi(pv.w) : (usebuf ? b[3] : 0.f);
#pragma unroll
                        for (int e = 0; e < 8; ++e) uu[e] += wc3[i][e] * x[e];
                    }
                    const f32x4 v0 = acc[ai][bj][m][0], v1 = acc[ai][bj][m][1];
                    u32x4 w; w.x = pk2(v0[0] * uu[0], v0[1] * uu[1]); w.y = pk2(v0[2] * uu[2], v0[3] * uu[3]); w.z = pk2(v1[0] * uu[4], v1[1] * uu[5]); w.w = pk2(v1[2] * uu[6], v1[3] * uu[7]);
                    *(u32x4*)(E.o0 + (size_t)row * 1024 + col) = w;
                }
        }
    } else {
        const bool sc = (E.mode == M_SCOUT);
#pragma unroll
        for (int ai = 0; ai < 2; ++ai)
#pragma unroll
            for (int m = 0; m < 4; ++m) {
                const int row = row0 + ai * HALF + m * 16;
#pragma unroll
                for (int bj = 0; bj < 2; ++bj) {
                    const size_t off = (size_t)row * 1024 + u.pn * 256 + bj * HALF + c8;
                    const u32x4 yv = *(const u32x4*)(E.o0 + off);
                    const f32x4 v0 = acc[ai][bj][m][0], v1 = acc[ai][bj][m][1];
                    float o[8];
                    if (sc) { const u32x4 gv = *(const u32x4*)(E.a0 + off);
                        o[0] = bflo(yv.x) + bflo(gv.x) * v0[0]; o[1] = bfhi(yv.x) + bfhi(gv.x) * v0[1]; o[2] = bflo(yv.y) + bflo(gv.y) * v0[2]; o[3] = bfhi(yv.y) + bfhi(gv.y) * v0[3];
                        o[4] = bflo(yv.z) + bflo(gv.z) * v1[0]; o[5] = bfhi(yv.z) + bfhi(gv.z) * v1[1]; o[6] = bflo(yv.w) + bflo(gv.w) * v1[2]; o[7] = bfhi(yv.w) + bfhi(gv.w) * v1[3];
                    } else {
                        o[0] = bflo(yv.x) * v0[0]; o[1] = bfhi(yv.x) * v0[1]; o[2] = bflo(yv.y) * v0[2]; o[3] = bfhi(yv.y) * v0[3];
                        o[4] = bflo(yv.z) * v1[0]; o[5] = bfhi(yv.z) * v1[1]; o[6] = bflo(yv.w) * v1[2]; o[7] = bfhi(yv.w) * v1[3];
                    }
                    u32x4 w; w.x = pk2(o[0], o[1]); w.y = pk2(o[2], o[3]); w.z = pk2(o[4], o[5]); w.w = pk2(o[6], o[7]);
                    *(u32x4*)(E.o0 + off) = w;
                }
            }
    }
}
__device__ __forceinline__ void epi_plain(const EpiArgs E, const f32x4 (&acc)[2][2][4][2], const Unit& u, int wr, int wc, int fr, int fq) {
    const int row0 = u.pm * BM + wr * 64 + fr, col0 = u.pn * BM + wc * 32 + 4 * fq;
    if (E.mode == M_F32) {
#pragma unroll
        for (int ai = 0; ai < 2; ++ai)
#pragma unroll
            for (int m = 0; m < 4; ++m) { float* rowp = E.fo0 + (size_t)(row0 + ai * HALF + m * 16) * 1024 + col0;
#pragma unroll
                for (int bj = 0; bj < 2; ++bj)
#pragma unroll
                    for (int n = 0; n < 2; ++n) *(f32x4*)(rowp + bj * HALF + n * 16) = acc[ai][bj][m][n]; }
    } else {
#pragma unroll
        for (int ai = 0; ai < 2; ++ai)
#pragma unroll
            for (int m = 0; m < 4; ++m) { const int row = row0 + ai * HALF + m * 16;
#pragma unroll
                for (int bj = 0; bj < 2; ++bj)
#pragma unroll
                    for (int n = 0; n < 2; ++n) { const int c = col0 + bj * HALF + n * 16; const f32x4 v = acc[ai][bj][m][n];
                        if (c < 1024) { *(f32x4*)(E.fo0 + (size_t)row * 1024 + c) = v; u32x2 w; w.x = pk2(v[0], v[1]); w.y = pk2(v[2], v[3]); *(u32x2*)(E.o0 + (size_t)row * 1024 + c) = w; }
                        else { const int c2 = c - 1024; *(f32x4*)(E.fo1 + (size_t)row * 1024 + c2) = v; const int seq = row >> 8, key = row & 255, hh = c2 >> 8, dim = c2 & 255;
                            bf16_t* d = E.o1 + ((size_t)((seq * 4 + hh) * 256 + dim)) * 256 + key;
                            d[0] = (bf16_t)(pk2(v[0], v[0]) & 0xffffu); d[256] = (bf16_t)(pk2(v[1], v[1]) & 0xffffu); d[512] = (bf16_t)(pk2(v[2], v[2]) & 0xffffu); d[768] = (bf16_t)(pk2(v[3], v[3]) & 0xffffu); } } }
    }
}

template <bool PERM>
__device__ __forceinline__ void gemm_phase(LAS unsigned char* lds, const Gemm g, const StaticOrder S, const EpiArgs E) {
    const int tid = threadIdx.x, wid = __builtin_amdgcn_readfirstlane(tid >> 6), lane = tid & 63, wr = wid >> 2, wc = wid & 3, fr = lane & 15, fq = lane >> 4;
    const int K = g.K, nt = K / BK;
    unsigned voffA[2], voffB[2];
#pragma unroll
    for (int i = 0; i < 2; ++i) { int R, C; stage_rc(tid * 16 + i * 8192, R, C); const int Rb = PERM ? ((R & ~31) + perm32(R & 31)) : R;
        voffA[i] = (unsigned)(R * K + C) * 2u; voffB[i] = (unsigned)(Rb * K + C) * 2u; }
    const size_t kstep = (size_t)(BK * 2);
    const size_t hstep = (size_t)HALF * K * 2;
    const size_t tstep = 2 * hstep;
    const unsigned ldsw = (unsigned)wid * 1024u;
    const int aoff = lds_byte(wr * 64 + fr, fq * 8), boff = lds_byte(wc * 32 + fr, fq * 8);
#define PG8_SA(b, h) (((b) * 2 + (h)) * HTB)
#define PG8_SB(b, h) ((4 + (b) * 2 + (h)) * HTB)
#define PG8_STAGE(bufoff, gbase, voff) do { _Pragma("unroll") for (int _i = 0; _i < 2; ++_i) \
        __builtin_amdgcn_global_load_lds((const unsigned*)((const char*)(gbase) + (voff)[_i]), (LAS unsigned*)(lds + (bufoff) + ldsw + _i * 8192), 16, 0, 0); } while (0)
#define PG8_LDA(dst, b, h) do { _Pragma("unroll") for (int m = 0; m < 4; ++m) _Pragma("unroll") for (int k = 0; k < 2; ++k) dst[m][k] = *(const LAS bf16x8*)(lds + PG8_SA(b, h) + aoff + m * 2048 + k * 1024); } while (0)
#define PG8_LDB(dst, b, h) do { _Pragma("unroll") for (int n = 0; n < 2; ++n) _Pragma("unroll") for (int k = 0; k < 2; ++k) dst[n][k] = *(const LAS bf16x8*)(lds + PG8_SB(b, h) + boff + n * 2048 + k * 1024); } while (0)
#define PG8_MMA(ai, bj, At, Bt) do { __builtin_amdgcn_s_setprio(1); _Pragma("unroll") for (int m = 0; m < 4; ++m) _Pragma("unroll") for (int n = 0; n < 2; ++n) _Pragma("unroll") for (int k = 0; k < 2; ++k) \
        acc[ai][bj][m][n] = __builtin_amdgcn_mfma_f32_16x16x32_bf16(Bt[n][k], At[m][k], acc[ai][bj][m][n], 0, 0, 0); __builtin_amdgcn_s_setprio(0); } while (0)
#define PG8_WAIT_V(n) asm volatile("s_waitcnt vmcnt(" #n ")" ::: "memory")
#define PG8_WAIT_L(n) asm volatile("s_waitcnt lgkmcnt(" #n ")" ::: "memory")
#define PG8_BAR __builtin_amdgcn_s_barrier()
#define PG8_SCHED __builtin_amdgcn_sched_barrier(0)
    Unit cur, nxt; int ui = 0;
    if (!S.next(0, cur)) return;
    f32x4 acc[2][2][4][2];
#pragma unroll
    for (int a = 0; a < 2; ++a)
#pragma unroll
        for (int b = 0; b < 2; ++b)
#pragma unroll
            for (int m = 0; m < 4; ++m)
#pragma unroll
                for (int n = 0; n < 2; ++n) acc[a][b][m][n] = (f32x4){0.f, 0.f, 0.f, 0.f};
    bf16x8 At[4][2], B0[2][2], B1[2][2];
    const char* cA = (const char*)g.A + (size_t)cur.pm * tstep; const char* cB = (const char*)g.Bt + (size_t)cur.pn * tstep;
    PG8_STAGE(PG8_SB(0, 0), cB, voffB); PG8_STAGE(PG8_SB(0, 1), cB + hstep, voffB); PG8_STAGE(PG8_SA(0, 0), cA, voffA); PG8_STAGE(PG8_SA(0, 1), cA + hstep, voffA);
    if (wr == 1) PG8_BAR;
    PG8_WAIT_V(0); PG8_BAR;
    PG8_STAGE(PG8_SB(1, 0), cB + kstep, voffB); PG8_STAGE(PG8_SA(1, 0), cA + kstep, voffA); PG8_STAGE(PG8_SB(1, 1), cB + hstep + kstep, voffB);
    PG8_WAIT_V(0); PG8_BAR;
    for (;;) {
        const bool has_next = S.next(ui + 1, nxt);
        const char* nA = has_next ? (const char*)g.A + (size_t)nxt.pm * tstep : cA; const char* nB = has_next ? (const char*)g.Bt + (size_t)nxt.pn * tstep : cB;
        for (int t = 0; t < nt; t += 2) {
            const bool last = (t == nt - 2);
            const char* a1 = cA + (size_t)(t + 1) * kstep;
            const char* a2 = last ? nA : cA + (size_t)(t + 2) * kstep; const char* b2 = last ? nB : cB + (size_t)(t + 2) * kstep;
            const char* a3 = a2 + kstep; const char* b3 = b2 + kstep;
            PG8_LDB(B0, 0, 0); PG8_LDB(B1, 0, 1); PG8_SCHED; PG8_LDA(At, 0, 0); PG8_STAGE(PG8_SA(1, 1), a1 + hstep, voffA);
            PG8_WAIT_V(8); PG8_WAIT_L(0); PG8_BAR; PG8_MMA(0, 0, At, B0); PG8_MMA(0, 1, At, B1); PG8_BAR; PG8_SCHED;
            PG8_LDA(At, 0, 1); PG8_STAGE(PG8_SB(0, 0), b2, voffB); PG8_STAGE(PG8_SB(0, 1), b2 + hstep, voffB); PG8_STAGE(PG8_SA(0, 0), a2, voffA);
            PG8_WAIT_V(8); PG8_WAIT_L(0); PG8_BAR; PG8_MMA(1, 0, At, B0); PG8_MMA(1, 1, At, B1); PG8_BAR; PG8_SCHED;
            PG8_LDB(B0, 1, 0); PG8_LDB(B1, 1, 1); PG8_SCHED; PG8_LDA(At, 1, 0); PG8_STAGE(PG8_SA(0, 1), a2 + hstep, voffA);
            PG8_WAIT_V(8); PG8_WAIT_L(0); PG8_BAR; PG8_MMA(0, 0, At, B0); PG8_MMA(0, 1, At, B1); PG8_BAR; PG8_SCHED;
            PG8_LDA(At, 1, 1); PG8_STAGE(PG8_SB(1, 0), b3, voffB); PG8_STAGE(PG8_SB(1, 1), b3 + hstep, voffB); PG8_STAGE(PG8_SA(1, 0), a3, voffA);
            PG8_WAIT_V(8); PG8_WAIT_L(0); PG8_BAR; PG8_MMA(1, 0, At, B0); PG8_MMA(1, 1, At, B1); PG8_BAR; PG8_SCHED;
        }
        if (wr == 0) PG8_BAR;
        if (PERM) epi_perm(E, acc, cur, wr, wc, fr, fq); else epi_plain(E, acc, cur, wr, wc, fr, fq);
        if (!has_next) break;
#pragma unroll
        for (int a = 0; a < 2; ++a)
#pragma unroll
            for (int b = 0; b < 2; ++b)
#pragma unroll
                for (int m = 0; m < 4; ++m)
#pragma unroll
                    for (int n = 0; n < 2; ++n) acc[a][b][m][n] = (f32x4){0.f, 0.f, 0.f, 0.f};
        cur = nxt; cA = nA; cB = nB; ++ui;
        if (wr == 1) PG8_BAR;
    }
    PG8_WAIT_V(0);
    PG8_BAR;
#undef PG8_SA
#undef PG8_SB
#undef PG8_STAGE
#undef PG8_LDA
#undef PG8_LDB
#undef PG8_MMA
#undef PG8_WAIT_V
#undef PG8_WAIT_L
#undef PG8_BAR
#undef PG8_SCHED
}
}

__device__ __forceinline__ void cvt_job(LAS unsigned char* lds, const float* __restrict__ src, int K, int ld, int N, int mode, int coloff, int halfoff, bf16_t* __restrict__ dst) {
    LAS float* tile0 = (LAS float*)lds;
    const int tid = threadIdx.x;
    const int nkt = K / 64, ntile = nkt * (N / 64);
    for (int t = blockIdx.x; t < ntile; t += 2 * gridDim.x) {
#pragma unroll
        for (int u = 0; u < 2; ++u) {
            const int tt = t + u * gridDim.x;
            if (tt < ntile) {
                LAS float* tile = tile0 + u * 4160;
                const int kt = tt % nkt, ntl = tt / nkt; const int k0 = kt * 64, n0 = ntl * 64;
                int sc;
                if (mode == 0) sc = coloff + n0; else { const int j = n0 >> 8, r = n0 & 255; sc = coloff + j * 128 + (r < 128 ? r : halfoff + (r - 128)); }
                const int kr = tid >> 4, c4 = (tid & 15) * 4;
#pragma unroll
                for (int i = 0; i < 2; ++i) { const int k = kr + 32 * i; const f32x4 v = __builtin_nontemporal_load((const f32x4*)(src + (size_t)(k0 + k) * ld + sc + c4));
                    tile[k * 65 + c4] = v[0]; tile[k * 65 + c4 + 1] = v[1]; tile[k * 65 + c4 + 2] = v[2]; tile[k * 65 + c4 + 3] = v[3]; }
            }
        }
        __syncthreads();
#pragma unroll
        for (int u = 0; u < 2; ++u) {
            const int tt = t + u * gridDim.x;
            if (tt < ntile) {
                LAS float* tile = tile0 + u * 4160;
                const int kt = tt % nkt, ntl = tt / nkt; const int k0 = kt * 64, n0 = ntl * 64;
                const int n = tid >> 3, k8 = (tid & 7) * 8; float f[8];
#pragma unroll
                for (int e = 0; e < 8; ++e) f[e] = tile[(k8 + e) * 65 + n];
                u32x4 w; w.x = pk2(f[0], f[1]); w.y = pk2(f[2], f[3]); w.z = pk2(f[4], f[5]); w.w = pk2(f[6], f[7]);
                *(u32x4*)(dst + (size_t)(n0 + n) * K + k0 + k8) = w;
            }
        }
        __syncthreads();
    }
}

__device__ __forceinline__ float wave_sum(float s) {
#pragma unroll
    for (int o = 32; o > 0; o >>= 1) s += __shfl_xor(s, o);
    return s;
}
__device__ __forceinline__ void rowpass(LAS unsigned char* lds, const float* xin0, const float* xin1, const bf16_t* xinb, const bf16_t* T, const float* gpost, float scale,
                        float* Xout, bf16_t* Xoutb, const float* gpre, bf16_t* Hout, int nrows, bool ab, const float* wmix, const float* a_log, const float* dt_bias, float* G, float* BETA) {
    const int tid = threadIdx.x, lane = tid & 63, w = tid >> 6;
    LAS float* wT = (LAS float*)lds;
    if (ab) { for (int idx = tid; idx < 16384; idx += 512) { const int k = idx >> 4, j = idx & 15; const int rem = k & 511; wT[j * 1024 + (((k >> 9) * 2 + ((rem & 7) >> 2)) * 256) + (rem >> 3) * 4 + (rem & 3)] = wmix[(size_t)k * 9232 + 4096 + j]; } __syncthreads(); }
    float gp[16], gq[16];
#pragma unroll
    for (int i = 0; i < 2; ++i)
#pragma unroll
        for (int h4 = 0; h4 < 2; ++h4) { const int c = lane * 8 + i * 512 + h4 * 4;
            const f32x4 a = gpre ? *(const f32x4*)(gpre + c) : (f32x4){0.f, 0.f, 0.f, 0.f}, b = gpost ? *(const f32x4*)(gpost + c) : (f32x4){0.f, 0.f, 0.f, 0.f};
#pragma unroll
            for (int e = 0; e < 4; ++e) { gq[i * 8 + h4 * 4 + e] = a[e]; gp[i * 8 + h4 * 4 + e] = b[e]; } }
    for (int row = blockIdx.x * 8 + w; row < nrows; row += gridDim.x * 8) {
        float v[16];
        if (xinb) {
#pragma unroll
            for (int i = 0; i < 2; ++i) { const u32x4 xv = __builtin_nontemporal_load((const u32x4*)(xinb + (size_t)row * 1024 + lane * 8 + i * 512));
                v[i * 8 + 0] = bflo(xv.x); v[i * 8 + 1] = bfhi(xv.x); v[i * 8 + 2] = bflo(xv.y); v[i * 8 + 3] = bfhi(xv.y); v[i * 8 + 4] = bflo(xv.z); v[i * 8 + 5] = bfhi(xv.z); v[i * 8 + 6] = bflo(xv.w); v[i * 8 + 7] = bfhi(xv.w); }
        } else {
            const float* xr = row < NPROMPT ? xin0 + (size_t)row * 1024 : xin1 + (size_t)(row - NPROMPT) * 1024;
#pragma unroll
            for (int i = 0; i < 2; ++i)
#pragma unroll
                for (int h4 = 0; h4 < 2; ++h4) { const f32x4 a = __builtin_nontemporal_load((const f32x4*)(xr + lane * 8 + i * 512 + h4 * 4));
#pragma unroll
                    for (int e = 0; e < 4; ++e) v[i * 8 + h4 * 4 + e] = a[e]; }
        }
        if (T) {
            float t[16]; float ss = 0.f;
#pragma unroll
            for (int i = 0; i < 2; ++i) { const u32x4 tv = __builtin_nontemporal_load((const u32x4*)(T + (size_t)row * 1024 + lane * 8 + i * 512));
                t[i * 8 + 0] = bflo(tv.x); t[i * 8 + 1] = bfhi(tv.x); t[i * 8 + 2] = bflo(tv.y); t[i * 8 + 3] = bfhi(tv.y); t[i * 8 + 4] = bflo(tv.z); t[i * 8 + 5] = bfhi(tv.z); t[i * 8 + 6] = bflo(tv.w); t[i * 8 + 7] = bfhi(tv.w); }
#pragma unroll
            for (int e = 0; e < 16; ++e) ss += t[e] * t[e];
            ss = wave_sum(ss);
            const float r = rsqrtf(ss * (1.0f / 1024.0f) + 1e-6f) * scale;
#pragma unroll
            for (int e = 0; e < 16; ++e) v[e] += t[e] * gp[e] * r;
        }
        if (Xout) {
#pragma unroll
            for (int i = 0; i < 2; ++i)
#pragma unroll
                for (int h4 = 0; h4 < 2; ++h4) __builtin_nontemporal_store((f32x4){v[i * 8 + h4 * 4], v[i * 8 + h4 * 4 + 1], v[i * 8 + h4 * 4 + 2], v[i * 8 + h4 * 4 + 3]}, (f32x4*)(Xout + (size_t)row * 1024 + lane * 8 + i * 512 + h4 * 4));
        }
        if (Xoutb) {
#pragma unroll
            for (int i = 0; i < 2; ++i) { u32x4 xw; xw.x = pk2(v[i * 8], v[i * 8 + 1]); xw.y = pk2(v[i * 8 + 2], v[i * 8 + 3]); xw.z = pk2(v[i * 8 + 4], v[i * 8 + 5]); xw.w = pk2(v[i * 8 + 6], v[i * 8 + 7]);
                *(u32x4*)(Xoutb + (size_t)row * 1024 + lane * 8 + i * 512) = xw; }
        }
        if (Hout) {
            float ss = 0.f;
#pragma unroll
            for (int e = 0; e < 16; ++e) ss += v[e] * v[e];
            ss = wave_sum(ss);
            const float r2 = rsqrtf(ss * (1.0f / 1024.0f) + 1e-6f);
            float h[16];
#pragma unroll
            for (int e = 0; e < 16; ++e) h[e] = v[e] * gq[e] * r2;
#pragma unroll
            for (int i = 0; i < 2; ++i) { u32x4 hw; hw.x = pk2(h[i * 8], h[i * 8 + 1]); hw.y = pk2(h[i * 8 + 2], h[i * 8 + 3]); hw.z = pk2(h[i * 8 + 4], h[i * 8 + 5]); hw.w = pk2(h[i * 8 + 6], h[i * 8 + 7]);
                *(u32x4*)(Hout + (size_t)row * 1024 + lane * 8 + i * 512) = hw; }
            if (ab) {
                float p[16];
#pragma unroll
                for (int j = 0; j < 16; ++j) { float s = 0.f;
#pragma unroll
                    for (int i = 0; i < 2; ++i)
#pragma unroll
                        for (int h4 = 0; h4 < 2; ++h4) { const f32x4 wv = *(const LAS f32x4*)(wT + j * 1024 + (i * 2 + h4) * 256 + lane * 4);
                            s += h[i * 8 + h4 * 4] * wv[0] + h[i * 8 + h4 * 4 + 1] * wv[1] + h[i * 8 + h4 * 4 + 2] * wv[2] + h[i * 8 + h4 * 4 + 3] * wv[3]; }
                    p[j] = s; }
                const bool b32 = (lane & 32) != 0, b16 = (lane & 16) != 0, b8 = (lane & 8) != 0, b4 = (lane & 4) != 0;
                float q8[8], q4[4], q2[2];
#pragma unroll
                for (int k = 0; k < 8; ++k) { const float snd = b32 ? p[k] : p[k + 8]; const float r = __shfl_xor(snd, 32); q8[k] = (b32 ? p[k + 8] : p[k]) + r; }
#pragma unroll
                for (int k = 0; k < 4; ++k) { const float snd = b16 ? q8[k] : q8[k + 4]; const float r = __shfl_xor(snd, 16); q4[k] = (b16 ? q8[k + 4] : q8[k]) + r; }
#pragma unroll
                for (int k = 0; k < 2; ++k) { const float snd = b8 ? q4[k] : q4[k + 2]; const float r = __shfl_xor(snd, 8); q2[k] = (b8 ? q4[k + 2] : q4[k]) + r; }
                float mine; { const float snd = b4 ? q2[0] : q2[1]; const float r = __shfl_xor(snd, 4); mine = (b4 ? q2[1] : q2[0]) + r; }
                mine += __shfl_xor(mine, 2); mine += __shfl_xor(mine, 1);
                const int jj = (b32 ? 8 : 0) + (b16 ? 4 : 0) + (b8 ? 2 : 0) + (b4 ? 1 : 0);
                if ((lane & 3) == 0) {
                    if (jj < 8) { const float x = mine + dt_bias[jj]; const float y = __expf(x); const float sp = x > 20.f ? x : (y < 1e-3f ? y * (1.0f - 0.5f * y) : __logf(1.0f + y)); G[(size_t)row * 8 + jj] = -__expf(a_log[jj]) * sp; }
                    else BETA[(size_t)row * 8 + jj - 8] = sigm_f(mine);
                }
            }
        }
    }
}

__device__ __forceinline__ void conv_phase(const bf16_t* RAW0, bf16_t* dstQ, bf16_t* dstK, bf16_t* dstV, int gi_lo, int gi_n, const float* wconv, const float* gbuf, float* gconv_p, float* gconv_s) {
    const int tid = threadIdx.x, lane = tid & 63, w = tid >> 6, r4 = lane >> 4, col = (lane & 15) * 8;
    const int nitems = NCH * gi_n;
    for (int it = blockIdx.x * 8 + w; it < nitems; it += gridDim.x * 8) {
        const int c = it / gi_n, gi = gi_lo + it % gi_n, which = gi >> 3, hd = gi & 7;
        const bf16_t* raw = RAW0 + (size_t)which * SLOT_E + hd * 128 + col;
        bf16_t* dst = (which == 0 ? dstQ : (which == 1 ? dstK : dstV)) + ((size_t)(c * 8 + hd) * 64) * 128 + col;
        int t0, sb; bool last;
        if (c < 1024) { t0 = (c & 127) * 64; sb = -1; last = (c & 127) == 127; } else { t0 = 0; sb = c - 1024; last = true; }
        const int l0 = r4 * 16;
        u32x4 rw[19];
#pragma unroll
        for (int jj = 0; jj < 19; ++jj) { long rg = (long)c * 64 + l0 - 3 + jj; rg = rg < 0 ? 0 : rg; rw[jj] = __builtin_nontemporal_load((const u32x4*)(raw + (size_t)rg * 1024)); }
        float wv[4][8];
#pragma unroll
        for (int i = 0; i < 4; ++i) { const f32x4 a = *(const f32x4*)(wconv + i * 3072 + gi * 128 + col), b = *(const f32x4*)(wconv + i * 3072 + gi * 128 + col + 4);
            wv[i][0] = a[0]; wv[i][1] = a[1]; wv[i][2] = a[2]; wv[i][3] = a[3]; wv[i][4] = b[0]; wv[i][5] = b[1]; wv[i][6] = b[2]; wv[i][7] = b[3]; }
        if (t0 == 0 && r4 == 0) {
#pragma unroll
            for (int jj = 0; jj < 3; ++jj) {
                u32x4 hv = {0u, 0u, 0u, 0u};
                if (sb >= 0) { const float* bp = gbuf + ((size_t)sb * 3 + jj) * 3072 + gi * 128 + col; const f32x4 a = *(const f32x4*)bp, b = *(const f32x4*)(bp + 4);
                    hv.x = pk2(a[0], a[1]); hv.y = pk2(a[2], a[3]); hv.z = pk2(b[0], b[1]); hv.w = pk2(b[2], b[3]); }
                rw[jj] = hv;
            }
        }
#pragma unroll
        for (int p = 0; p < 16; ++p) {
            const int l = l0 + p; float acc[8];
#pragma unroll
            for (int e = 0; e < 8; ++e) acc[e] = 0.f;
            { f32x2v a01 = {0.f, 0.f}, a23 = {0.f, 0.f}, a45 = {0.f, 0.f}, a67 = {0.f, 0.f};
#pragma unroll
              for (int i = 0; i < 4; ++i) { const u32x4 pv = rw[p + i];
                  a01 += (f32x2v){wv[i][0], wv[i][1]} * (f32x2v){bflo(pv.x), bfhi(pv.x)}; a23 += (f32x2v){wv[i][2], wv[i][3]} * (f32x2v){bflo(pv.y), bfhi(pv.y)};
                  a45 += (f32x2v){wv[i][4], wv[i][5]} * (f32x2v){bflo(pv.z), bfhi(pv.z)}; a67 += (f32x2v){wv[i][6], wv[i][7]} * (f32x2v){bflo(pv.w), bfhi(pv.w)}; }
              acc[0] = a01[0]; acc[1] = a01[1]; acc[2] = a23[0]; acc[3] = a23[1]; acc[4] = a45[0]; acc[5] = a45[1]; acc[6] = a67[0]; acc[7] = a67[1]; }
            float y[8];
#pragma unroll
            for (int e = 0; e < 8; ++e) y[e] = silu_f(acc[e]);
            if (which < 2) {
                float ss = 0.f;
#pragma unroll
                for (int e = 0; e < 8; ++e) ss += y[e] * y[e];
                ss += __shfl_xor(ss, 1); ss += __shfl_xor(ss, 2); ss += __shfl_xor(ss, 4); ss += __shfl_xor(ss, 8);
                const float r = rsqrtf(ss + 1e-6f) * (which == 0 ? 0.08838834764831845f : 1.0f);
#pragma unroll
                for (int e = 0; e < 8; ++e) y[e] *= r;
            }
            u32x4 ov; ov.x = pk2(y[0], y[1]); ov.y = pk2(y[2], y[3]); ov.z = pk2(y[4], y[5]); ov.w = pk2(y[6], y[7]);
            *(u32x4*)(dst + (size_t)l * 128) = ov;
            if (last && l >= 61) {
                const u32x4 pv = rw[p + 3];
                float* o = (sb < 0 ? gconv_p + ((size_t)(c >> 7) * 3 + (l - 61)) * 3072 : gconv_s + ((size_t)sb * 3 + (l - 61)) * 3072) + gi * 128 + col;
                *(f32x4*)o = (f32x4){bflo(pv.x), bfhi(pv.x), bflo(pv.y), bfhi(pv.y)}; *(f32x4*)(o + 4) = (f32x4){bflo(pv.z), bfhi(pv.z), bflo(pv.w), bfhi(pv.w)};
            }
        }
    }
}

__device__ __forceinline__ void og_phase(bf16_t* ZG, const bf16_t* Ob, const float* SSQ, const float* gnorm, const bf16_t* P, float* sc_p, float* sc_s) {
    const int tid = threadIdx.x, lane = tid & 63, w = tid >> 6, r4 = lane >> 4, col = (lane & 15) * 8;
    const f32x4 g0 = *(const f32x4*)(gnorm + col), g1 = *(const f32x4*)(gnorm + col + 4);
    for (int idx = blockIdx.x * 512 + tid; idx < 24 * 2048; idx += gridDim.x * 512) {
        const int seq = idx >> 11, r = (idx >> 10) & 1, cl = idx & 1023;
        const int row = seq < 8 ? seq * 8192 + 8190 + r : NPROMPT + (seq - 8) * 64 + 62 + r;
        float* dst = seq < 8 ? sc_p + (size_t)(seq * 2 + r) * 1024 + cl : sc_s + (size_t)((seq - 8) * 2 + r) * 1024 + cl;
        *dst = bf2f(P[(size_t)row * 1024 + cl]);
    }
    const int nitems = M_TOK * 8 / 4;
    for (int it = blockIdx.x * 8 + w; it < nitems; it += gridDim.x * 8) {
        const int head = it & 7, row = (it >> 3) * 4 + r4;
        const u32x4 ov = *(const u32x4*)(Ob + ((size_t)((row >> 6) * 8 + head) * 64) * 128 + (col >> 5) * 2048 + (row & 63) * 32 + (col & 31));
        const u32x4 zv = *(const u32x4*)(ZG + (size_t)row * 1024 + head * 128 + col);
        float ss = (bflo(ov.x) * bflo(ov.x) + bfhi(ov.x) * bfhi(ov.x)) + (bflo(ov.y) * bflo(ov.y) + bfhi(ov.y) * bfhi(ov.y)) + (bflo(ov.z) * bflo(ov.z) + bfhi(ov.z) * bfhi(ov.z)) + (bflo(ov.w) * bflo(ov.w) + bfhi(ov.w) * bfhi(ov.w));
        ss += __shfl_xor(ss, 1); ss += __shfl_xor(ss, 2); ss += __shfl_xor(ss, 4); ss += __shfl_xor(ss, 8);
        const float rs = rsqrtf(ss * (1.0f / 128.0f) + 1e-6f);
        u32x4 wv;
        wv.x = pk2(bflo(ov.x) * rs * g0[0] * bflo(zv.x), bfhi(ov.x) * rs * g0[1] * bfhi(zv.x));
        wv.y = pk2(bflo(ov.y) * rs * g0[2] * bflo(zv.y), bfhi(ov.y) * rs * g0[3] * bfhi(zv.y));
        wv.z = pk2(bflo(ov.z) * rs * g1[0] * bflo(zv.z), bfhi(ov.z) * rs * g1[1] * bfhi(zv.z));
        wv.w = pk2(bflo(ov.w) * rs * g1[2] * bflo(zv.w), bfhi(ov.w) * rs * g1[3] * bfhi(zv.w));
        *(u32x4*)(ZG + (size_t)row * 1024 + head * 128 + col) = wv;
    }
}

__device__ __forceinline__ void chunk_phase(LAS unsigned char* lds, bf16_t* Qb, bf16_t* Kb, bf16_t* Vb, bf16_t* Wb, bf16_t* QKM, const float* G, const float* BETA, float* GC) {
    const int tid = threadIdx.x, half = tid >> 8, ht = tid & 255, lane = tid & 63, hw = (tid >> 6) & 3, fr = lane & 15, fq = lane >> 4;
    LAS unsigned char* base = lds + half * 71680;
    LAS bf16_t* sQ = (LAS bf16_t*)base; LAS bf16_t* sK = (LAS bf16_t*)(base + 17408); LAS bf16_t* sV = (LAS bf16_t*)(base + 34816);
    LAS float* sAt = (LAS float*)(base + 52224);
    LAS float* sgc = (LAS float*)(base + 69632); LAS float* sb1 = sgc + 64; LAS float* sb2 = sgc + 128;
    const int npair = NCH * 4;
    u32x4 fq_[4], fk_[4];
#define CH_PREF(prr) do { const int it_ = (prr) * 2 + half; const size_t tb_ = ((size_t)((it_ >> 3) * 8 + (it_ & 7)) * 64) * 128; \
        _Pragma("unroll") for (int i = 0; i < 4; ++i) { const int ch = ht + 256 * i; fq_[i] = __builtin_nontemporal_load((const u32x4*)(Qb + tb_ + ch * 8)); fk_[i] = __builtin_nontemporal_load((const u32x4*)(Kb + tb_ + ch * 8)); } } while (0)
    if ((int)blockIdx.x < npair) CH_PREF(blockIdx.x);
    for (int pr = blockIdx.x; pr < npair; pr += gridDim.x) {
        const int it = pr * 2 + half, c = it >> 3, h = it & 7;
        const size_t tb = ((size_t)(c * 8 + h) * 64) * 128;
#pragma unroll
        for (int i = 0; i < 4; ++i) { const int ch = ht + 256 * i, row = ch >> 4, c16 = ch & 15;
            *(LAS u32x4*)(sQ + row * 136 + c16 * 8) = fq_[i];
            *(LAS u32x4*)(sK + row * 136 + c16 * 8) = fk_[i];
            *(LAS u32x4*)(sV + row * 136 + c16 * 8) = __builtin_nontemporal_load((const u32x4*)(Vb + tb + ch * 8)); }
        if (hw == 0) {
            const float g = G[(size_t)(c * 64 + lane) * 8 + h], b = BETA[(size_t)(c * 64 + lane) * 8 + h];
            float s = g;
#pragma unroll
            for (int o = 1; o < 64; o <<= 1) { const float t = __shfl_up(s, o); if (lane >= o) s += t; }
            sgc[lane] = s; sb1[lane] = b; sb2[lane] = b * __expf(s); GC[(size_t)(c * 8 + h) * 64 + lane] = s;
        }
        __syncthreads();
        if (pr + (int)gridDim.x < npair) CH_PREF(pr + gridDim.x);
        {
            const int lt = hw;
            bf16x8 ak[4], aq[4];
#pragma unroll
            for (int kk = 0; kk < 4; ++kk) { ak[kk] = *(const LAS bf16x8*)(sK + (lt * 16 + fr) * 136 + kk * 32 + fq * 8); aq[kk] = *(const LAS bf16x8*)(sQ + (lt * 16 + fr) * 136 + kk * 32 + fq * 8); }
#pragma unroll
            for (int mt = 0; mt < 4; ++mt) {
                bf16x8 bk[4];
#pragma unroll
                for (int kk = 0; kk < 4; ++kk) bk[kk] = *(const LAS bf16x8*)(sK + (mt * 16 + fr) * 136 + kk * 32 + fq * 8);
                f32x4 dq = {0.f, 0.f, 0.f, 0.f};
#pragma unroll
                for (int kk = 0; kk < 4; ++kk) dq = mfma16(bk[kk], aq[kk], dq);
                { const int l = lt * 16 + fr; const float gl = sgc[l]; float o[4];
#pragma unroll
                  for (int r = 0; r < 4; ++r) { const int m = mt * 16 + fq * 4 + r; o[r] = (l >= m) ? dq[r] * __expf(gl - sgc[m]) : 0.f; }
                  u32x2 wv; wv.x = pk2(o[0], o[1]); wv.y = pk2(o[2], o[3]);
                  *(u32x2*)(QKM + ((size_t)(c * 8 + h) * 64 + l) * 64 + mt * 16 + fq * 4) = wv; }
                if (mt <= lt) {
                    f32x4 dk = {0.f, 0.f, 0.f, 0.f};
#pragma unroll
                    for (int kk = 0; kk < 4; ++kk) dk = mfma16(ak[kk], bk[kk], dk);
                    const int m = mt * 16 + fr; const float gm = sgc[m]; f32x4 a;
#pragma unroll
                    for (int r = 0; r < 4; ++r) { const int l = lt * 16 + fq * 4 + r; a[r] = (l > m) ? sb1[l] * dk[r] * __expf(sgc[l] - gm) : 0.f; }
                    *(LAS f32x4*)(sAt + m * 68 + lt * 16 + fq * 4) = a;
                }
            }
        }
        __syncthreads();
        {
            float sol[64];
            if (ht < 128) {
#pragma unroll
                for (int l = 0; l < 64; ++l) sol[l] = bf2f(sV[l * 136 + ht]) * sb1[l];
            } else {
#pragma unroll
                for (int l = 0; l < 64; ++l) sol[l] = bf2f(sK[l * 136 + ht - 128]) * sb2[l];
            }
#pragma unroll
            for (int m = 0; m < 63; ++m) { const float x = sol[m];
#pragma unroll
                for (int q4 = (m + 1) >> 2; q4 < 16; ++q4) { const f32x4 a4 = *(const LAS f32x4*)(sAt + m * 68 + q4 * 4);
#pragma unroll
                    for (int e = 0; e < 4; ++e) { const int l = q4 * 4 + e; if (l > m) sol[l] -= a4[e] * x; } } }
            if (ht < 128) { bf16_t* dstp = Vb + tb + (ht >> 5) * 2048 + (ht & 31);
#pragma unroll
                for (int l = 0; l < 64; ++l) dstp[l * 32] = (bf16_t)(pk2(sol[l], sol[l]) & 0xffffu);
            } else { bf16_t* dstp = Wb + tb + (ht - 128);
#pragma unroll
                for (int l = 0; l < 64; ++l) dstp[l * 128] = (bf16_t)(pk2(sol[l], sol[l]) & 0xffffu);
            }
        }
        {
            const float gend = sgc[63];
#pragma unroll
            for (int i = 0; i < 4; ++i) { const int ch = ht + 256 * i, row = ch >> 4, c16 = ch & 15; const float gr = sgc[row]; const float eq = __expf(gr), ek = __expf(gend - gr);
                const u32x4 q = *(const LAS u32x4*)(sQ + row * 136 + c16 * 8), k = *(const LAS u32x4*)(sK + row * 136 + c16 * 8);
                u32x4 qo, ko;
                qo.x = pk2(bflo(q.x) * eq, bfhi(q.x) * eq); qo.y = pk2(bflo(q.y) * eq, bfhi(q.y) * eq); qo.z = pk2(bflo(q.z) * eq, bfhi(q.z) * eq); qo.w = pk2(bflo(q.w) * eq, bfhi(q.w) * eq);
                ko.x = pk2(bflo(k.x) * ek, bfhi(k.x) * ek); ko.y = pk2(bflo(k.y) * ek, bfhi(k.y) * ek); ko.z = pk2(bflo(k.z) * ek, bfhi(k.z) * ek); ko.w = pk2(bflo(k.w) * ek, bfhi(k.w) * ek);
                *(u32x4*)(Qb + tb + ch * 8) = qo; *(u32x4*)(Kb + tb + ch * 8) = ko; }
        }
        __syncthreads();
    }
}

#undef CH_PREF
__device__ __forceinline__ void scan_phase(LAS unsigned char* lds, const bf16_t* Wb, const bf16_t* Qb, const bf16_t* Kb, bf16_t* UOb, const bf16_t* QKM, const float* GC, float* SSQ,
                           const float* state_in, float* st_p, float* st_s) {
    const int tid = threadIdx.x, lane = tid & 63, w = tid >> 6, fr = lane & 15, fq = lane >> 4;
    LAS bf16_t* sW = (LAS bf16_t*)lds; LAS bf16_t* sQ = (LAS bf16_t*)(lds + 17408); LAS bf16_t* sK = (LAS bf16_t*)(lds + 34816);
    LAS bf16_t* sQK = (LAS bf16_t*)(lds + 52224); LAS bf16_t* sU = (LAS bf16_t*)(lds + 61440); LAS bf16_t* sSt = (LAS bf16_t*)(lds + 65536); LAS bf16_t* sUt = (LAS bf16_t*)(lds + 74240);
    const int kt = w, lt = w & 3, vtw = w >> 2;
    for (int j = blockIdx.x; j < 768; j += gridDim.x) {
        int h, slice, c0, nch; const float* Sin; float* Sout;
        if (j < 256) { const int xcd = j & 7, idx = j >> 3, stream = xcd * 8 + (idx >> 2), seq = stream >> 3; h = stream & 7; slice = idx & 3; c0 = seq * 128; nch = 128; Sin = nullptr; Sout = st_p + (size_t)(seq * 8 + h) * 16384; }
        else { const int q = j - 256, sb = q >> 5; h = (q >> 2) & 7; slice = q & 3; c0 = 1024 + sb; nch = 1; Sin = state_in + (size_t)(sb * 8 + h) * 16384; Sout = st_s + (size_t)(sb * 8 + h) * 16384; }
        f32x4 S[2];
#pragma unroll
        for (int vt = 0; vt < 2; ++vt) {
#pragma unroll
            for (int r = 0; r < 4; ++r) S[vt][r] = Sin ? Sin[(kt * 16 + fq * 4 + r) * 128 + slice * 32 + vt * 16 + fr] : 0.f;
            u32x2 wv; wv.x = pk2n(S[vt][0], S[vt][1]); wv.y = pk2n(S[vt][2], S[vt][3]);
            *(LAS u32x2*)(sSt + (vt * 16 + fr) * 136 + kt * 16 + fq * 4) = wv;
        }
        u32x4 pw[2], pq[2], pkk[2], pqk, pu = {0u, 0u, 0u, 0u}; float geg;
#define SC_PREF(cc) do { const size_t tb_ = ((size_t)((cc) * 8 + h) * 64) * 128; \
        _Pragma("unroll") for (int i_ = 0; i_ < 2; ++i_) { const int ch_ = tid + 512 * i_; pw[i_] = *(const u32x4*)(Wb + tb_ + ch_ * 8); pq[i_] = *(const u32x4*)(Qb + tb_ + ch_ * 8); pkk[i_] = *(const u32x4*)(Kb + tb_ + ch_ * 8); } \
        pqk = *(const u32x4*)(QKM + ((size_t)((cc) * 8 + h) * 64) * 64 + tid * 8); \
        if (tid < 256) pu = *(const u32x4*)(UOb + tb_ + slice * 2048 + (tid >> 2) * 32 + (tid & 3) * 8); \
        geg = GC[(size_t)((cc) * 8 + h) * 64 + 63]; } while (0)
#define SC_PSTORE() do { _Pragma("unroll") for (int i_ = 0; i_ < 2; ++i_) { const int ch_ = tid + 512 * i_, row_ = ch_ >> 4, c16_ = ch_ & 15; \
            *(LAS u32x4*)(sW + row_ * 136 + c16_ * 8) = pw[i_]; *(LAS u32x4*)(sQ + row_ * 136 + c16_ * 8) = pq[i_]; *(LAS u32x4*)(sK + row_ * 136 + c16_ * 8) = pkk[i_]; } \
        *(LAS u32x4*)(sQK + (tid >> 3) * 72 + (tid & 7) * 8) = pqk; \
        if (tid < 256) *(LAS u32x4*)(sU + (tid >> 2) * 32 + (tid & 3) * 8) = pu; } while (0)
        SC_PREF(c0); SC_PSTORE(); float eg_cur = geg;
        __syncthreads();
        for (int ci = 0; ci < nch; ++ci) {
            const int c = c0 + ci;
            const float eg = __expf(eg_cur);
            if (ci + 1 < nch) SC_PREF(c + 1);
            {
                f32x4 d = {0.f, 0.f, 0.f, 0.f};
#pragma unroll
                for (int kk = 0; kk < 4; ++kk) d = mfma16(*(const LAS bf16x8*)(sW + (lt * 16 + fr) * 136 + kk * 32 + fq * 8), *(const LAS bf16x8*)(sSt + (vtw * 16 + fr) * 136 + kk * 32 + fq * 8), d);
                float u[4];
#pragma unroll
                for (int r = 0; r < 4; ++r) u[r] = bf2f(sU[(lt * 16 + fq * 4 + r) * 32 + vtw * 16 + fr]) - d[r];
                u32x2 wv; wv.x = pk2(u[0], u[1]); wv.y = pk2(u[2], u[3]);
                *(LAS u32x2*)(sUt + (vtw * 16 + fr) * 72 + lt * 16 + fq * 4) = wv;
            }
            __syncthreads();
            {
                f32x4 d = {0.f, 0.f, 0.f, 0.f};
#pragma unroll
                for (int kk = 0; kk < 4; ++kk) d = mfma16(*(const LAS bf16x8*)(sSt + (vtw * 16 + fr) * 136 + kk * 32 + fq * 8), *(const LAS bf16x8*)(sQ + (lt * 16 + fr) * 136 + kk * 32 + fq * 8), d);
#pragma unroll
                for (int k2 = 0; k2 < 2; ++k2) d = mfma16(*(const LAS bf16x8*)(sUt + (vtw * 16 + fr) * 72 + k2 * 32 + fq * 8), *(const LAS bf16x8*)(sQK + (lt * 16 + fr) * 72 + k2 * 32 + fq * 8), d);
                const int l = lt * 16 + fr;
                u32x2 wv; wv.x = pk2n(d[0], d[1]); wv.y = pk2n(d[2], d[3]);
                *(u32x2*)(UOb + ((size_t)(c * 8 + h) * 64) * 128 + slice * 2048 + l * 32 + vtw * 16 + fq * 4) = wv;
                float s = d[0] * d[0] + d[1] * d[1] + d[2] * d[2] + d[3] * d[3];
                s += __shfl_xor(s, 16); s += __shfl_xor(s, 32);
                if (fq == 0) SSQ[((size_t)(c * 64 + l) * 8 + h) * 8 + slice * 2 + vtw] = s;
            }
            {
                S[0] *= eg; S[1] *= eg;
#pragma unroll
                for (int k2 = 0; k2 < 2; ++k2) {
                    bf16x8 a;
#pragma unroll
                    for (int e = 0; e < 8; ++e) a[e] = (short)sK[(k2 * 32 + fq * 8 + e) * 136 + kt * 16 + fr];
#pragma unroll
                    for (int vt = 0; vt < 2; ++vt) S[vt] = mfma16(a, *(const LAS bf16x8*)(sUt + (vt * 16 + fr) * 72 + k2 * 32 + fq * 8), S[vt]);
                }
            }
            __syncthreads();
#pragma unroll
            for (int vt = 0; vt < 2; ++vt) { u32x2 wv; wv.x = pk2n(S[vt][0], S[vt][1]); wv.y = pk2n(S[vt][2], S[vt][3]); *(LAS u32x2*)(sSt + (vt * 16 + fr) * 136 + kt * 16 + fq * 4) = wv; }
            if (ci + 1 < nch) { SC_PSTORE(); eg_cur = geg; }
            __syncthreads();
        }
#pragma unroll
        for (int vt = 0; vt < 2; ++vt)
#pragma unroll
            for (int r = 0; r < 4; ++r) Sout[(kt * 16 + fq * 4 + r) * 128 + slice * 32 + vt * 16 + fr] = S[vt][r];
        __syncthreads();
#undef SC_PREF
#undef SC_PSTORE
    }
}

__device__ __forceinline__ void attn_phase(LAS unsigned char* lds, const bf16_t* QX, const bf16_t* KX, const bf16_t* VXT, bf16_t* AO) {
    const int tid = threadIdx.x, lane = tid & 63, w = tid >> 6, fr = lane & 15, fq = lane >> 4;
    LAS bf16_t* sm = (LAS bf16_t*)lds;
    const int nitems = 1024 + 64;
    for (int it = blockIdx.x; it < nitems; it += gridDim.x) {
        int seq, hh, row0, nrows;
        if (it < 1024) { seq = it >> 7; hh = (it >> 5) & 3; row0 = seq * 8192 + (it & 31) * 256; nrows = 256; }
        else { const int q = it - 1024; seq = 8 + (q >> 2); hh = q & 3; row0 = NPROMPT + (q >> 2) * 64; nrows = 64; }
        const bool act = w * 32 < nrows;
#pragma unroll
        for (int i = 0; i < 16; ++i) { const int ch = tid + 512 * i, key = ch >> 5, c32 = ch & 31;
            *(LAS u32x4*)(sm + key * 264 + c32 * 8) = *(const u32x4*)(KX + ((size_t)(seq * 256 + key)) * 1024 + hh * 256 + c32 * 8); }
        const int rowa = row0 + w * 32 + fr;
        u32x4 pf[2][8];
#pragma unroll
        for (int rt = 0; rt < 2; ++rt)
#pragma unroll
            for (int T = 0; T < 8; ++T) pf[rt][T] = (u32x4){0u, 0u, 0u, 0u};
        __syncthreads();
        if (act) {
#pragma unroll
            for (int rt = 0; rt < 2; ++rt) {
                bf16x8 qf[8];
#pragma unroll
                for (int kk = 0; kk < 8; ++kk) qf[kk] = __builtin_nontemporal_load((const bf16x8*)(QX + (size_t)(rowa + rt * 16) * 1024 + hh * 256 + kk * 32 + fq * 8));
                f32x4 sc[16];
#pragma unroll
                for (int t = 0; t < 16; ++t) { f32x4 d = {0.f, 0.f, 0.f, 0.f};
#pragma unroll
                    for (int kk = 0; kk < 8; ++kk) d = mfma16(*(const LAS bf16x8*)(sm + (t * 16 + fr) * 264 + kk * 32 + fq * 8), qf[kk], d);
                    sc[t] = d; }
                float mx = -3.0e38f;
#pragma unroll
                for (int t = 0; t < 16; ++t)
#pragma unroll
                    for (int r = 0; r < 4; ++r) mx = fmaxf(mx, sc[t][r]);
                mx = fmaxf(mx, __shfl_xor(mx, 16)); mx = fmaxf(mx, __shfl_xor(mx, 32));
                float sum = 0.f;
#pragma unroll
                for (int t = 0; t < 16; ++t)
#pragma unroll
                    for (int r = 0; r < 4; ++r) { sc[t][r] = __expf(sc[t][r] - mx); sum += sc[t][r]; }
                sum += __shfl_xor(sum, 16); sum += __shfl_xor(sum, 32);
                const float inv = 1.0f / sum;
#pragma unroll
                for (int T = 0; T < 8; ++T) { pf[rt][T].x = pk2(sc[2 * T][0] * inv, sc[2 * T][1] * inv); pf[rt][T].y = pk2(sc[2 * T][2] * inv, sc[2 * T][3] * inv);
                    pf[rt][T].z = pk2(sc[2 * T + 1][0] * inv, sc[2 * T + 1][1] * inv); pf[rt][T].w = pk2(sc[2 * T + 1][2] * inv, sc[2 * T + 1][3] * inv); }
            }
        }
        __syncthreads();
#pragma unroll
        for (int i = 0; i < 16; ++i) { const int ch = tid + 512 * i, dim = ch >> 5, c32 = ch & 31;
            *(LAS u32x4*)(sm + dim * 264 + c32 * 8) = *(const u32x4*)(VXT + ((size_t)((seq * 4 + hh) * 256 + dim)) * 256 + c32 * 8); }
        __syncthreads();
        if (act) {
#pragma unroll
            for (int dt = 0; dt < 16; ++dt) { f32x4 d0 = {0.f, 0.f, 0.f, 0.f}, d1 = {0.f, 0.f, 0.f, 0.f};
#pragma unroll
                for (int T = 0; T < 8; ++T) { const u32x2 lo = *(const LAS u32x2*)(sm + (dt * 16 + fr) * 264 + T * 32 + fq * 4), hi = *(const LAS u32x2*)(sm + (dt * 16 + fr) * 264 + T * 32 + 16 + fq * 4);
                    const bf16x8 vf = as_bf((u32x4){lo.x, lo.y, hi.x, hi.y});
                    d0 = mfma16(vf, as_bf(pf[0][T]), d0); d1 = mfma16(vf, as_bf(pf[1][T]), d1); }
                u32x2 w0; w0.x = pk2n(d0[0], d0[1]); w0.y = pk2n(d0[2], d0[3]);
                u32x2 w1; w1.x = pk2n(d1[0], d1[1]); w1.y = pk2n(d1[2], d1[3]);
                *(u32x2*)(AO + (size_t)rowa * 1024 + hh * 256 + dt * 16 + fq * 4) = w0;
                *(u32x2*)(AO + (size_t)(rowa + 16) * 1024 + hh * 256 + dt * 16 + fq * 4) = w1; }
        }
        __syncthreads();
    }
}


#define XB_TMO      128
#define XB_XCNT(j)  (256  + 64 * (j))
#define XB_XSUB(j)  (1280 + 64 * (j))
#define XB_XGEN(j)  (2304 + 64 * (j))
#define XB_TOP      3328
#define XB_TOPGEN   3392
#define XCD_BAR_WORDS 3456
#define XB_SPIN_CAP (1u << 18)
__device__ __forceinline__ unsigned xb_ld(unsigned* p)              { return __hip_atomic_load(p, __ATOMIC_RELAXED, __HIP_MEMORY_SCOPE_AGENT); }
__device__ __forceinline__ unsigned xb_add(unsigned* p, unsigned v) { return __hip_atomic_fetch_add(p, v, __ATOMIC_RELAXED, __HIP_MEMORY_SCOPE_AGENT); }
__device__ __forceinline__ unsigned xb_xcc_id() { return (unsigned)__builtin_amdgcn_s_getreg((3 << 11) | 20) & 0xFu; }
#define XB_SPIN(cond, bar) do { unsigned _sp = 0; while (cond) { __builtin_amdgcn_s_sleep(1); \
    if ((++_sp & 255u) == 0u) { if (xb_ld(&(bar)[XB_TMO])) break; if (_sp > XB_SPIN_CAP) { atomicAdd(&(bar)[XB_TMO], 1u); break; } } } } while (0)
struct XcdBarrier { unsigned* bar; unsigned x; volatile LAS unsigned* st; };
__device__ __forceinline__ XcdBarrier xcd_barrier_post(unsigned* bar, volatile LAS unsigned* st) {
    XcdBarrier b; b.bar = bar; b.x = xb_xcc_id(); b.st = st;
    if (threadIdx.x == 0) (void)xb_add(&bar[XB_XCNT(b.x)], 1u);
    return b;
}
__device__ __forceinline__ void xcd_barrier_complete(unsigned* bar, unsigned x, unsigned& nloc, unsigned& nx) {
    const unsigned G = gridDim.x * gridDim.y * gridDim.z;
    unsigned sum, cnt, mine, sp = 0u;
    for (;;) {
        sum = 0u; cnt = 0u; mine = 0u;
#pragma unroll
        for (unsigned j = 0; j < 16; ++j) { const unsigned c = xb_ld(&bar[XB_XCNT(j)]); sum += c; cnt += (c > 0u) ? 1u : 0u; mine = (j == x) ? c : mine; }
        if (sum == G) break;
        __builtin_amdgcn_s_sleep(1);
        if ((++sp & 255u) == 0u) { if (xb_ld(&bar[XB_TMO])) break; if (sp > XB_SPIN_CAP) { atomicAdd(&bar[XB_TMO], 1u); break; } }
    }
    nloc = mine > 0u ? mine : 1u; nx = cnt > 0u ? cnt : 1u;
}
__device__ __forceinline__ void xcd_barrier(const XcdBarrier& b) {
    asm volatile("s_waitcnt vmcnt(0)" ::: "memory");
    __syncthreads();
    if (threadIdx.x == 0) {
        unsigned* bar = b.bar;
        __builtin_amdgcn_s_waitcnt(0);
        unsigned nloc = b.st[0], nx = b.st[1];
        if (nloc == 0u) { xcd_barrier_complete(bar, b.x, nloc, nx); b.st[0] = nloc; b.st[1] = nx; }
        const unsigned old = xb_add(&bar[XB_XSUB(b.x)], 1u);
        const unsigned gen = old / nloc;
        if (old + 1u == (gen + 1u) * nloc) {
            __builtin_amdgcn_fence(__ATOMIC_RELEASE, "agent");
            asm volatile("s_waitcnt vmcnt(0)" ::: "memory");
            const unsigned og = xb_add(&bar[XB_TOP], 1u);
            const unsigned tg = og / nx;
            if (og + 1u == (tg + 1u) * nx) xb_add(&bar[XB_TOPGEN], 1u);
            else XB_SPIN(xb_ld(&bar[XB_TOPGEN]) == tg, bar);
            __builtin_amdgcn_fence(__ATOMIC_ACQUIRE, "agent");
            xb_add(&bar[XB_XGEN(b.x)], 1u);
            asm volatile("s_waitcnt vmcnt(0)" ::: "memory");
        } else {
            XB_SPIN(xb_ld(&bar[XB_XGEN(b.x)]) == gen, bar);
            __builtin_amdgcn_fence(__ATOMIC_ACQUIRE, "agent");
            asm volatile("s_waitcnt vmcnt(0)" ::: "memory");
        }
    }
    __syncthreads();
}

struct Args { const float* in[33]; float* out; unsigned char* ws; int ph_lo, ph_hi; };

__global__ void __launch_bounds__(512, 2) fwd_kernel(Args a) {
    extern __shared__ __attribute__((aligned(16))) unsigned char lds_raw[];
    LAS unsigned char* lds = (LAS unsigned char*)lds_raw;
    cg::grid_group grid = cg::this_grid();
    const int lo = a.ph_lo, hi = a.ph_hi, G = gridDim.x, bid = blockIdx.x;
    unsigned char* const ws = a.ws;
    volatile LAS unsigned* bst = (volatile LAS unsigned*)(lds + (LDS_BYTES - 16));
    if (threadIdx.x == 0) { bst[0] = 0u; bst[1] = 0u; }
    __syncthreads();
    const XcdBarrier xbar = xcd_barrier_post((unsigned*)(ws + OFF_BAR), bst);
    if (hi < 0) grid.sync();
    using namespace pg8;
#define WBp ((bf16_t*)(ws + OFF_WB))
#define Gd ((float*)(ws + OFF_G))
#define BETAp ((float*)(ws + OFF_BETA))
#define GCp ((float*)(ws + OFF_GC))
#define SSQp ((float*)(ws + OFF_SSQ))
#define MHp ((bf16_t*)(ws + OFF_MH))
#define KXp ((bf16_t*)(ws + OFF_KX))
#define VXTp ((bf16_t*)(ws + OFF_VXT))
#define SL(i) ((bf16_t*)(ws + OFF_SLOTS + (size_t)(i) * SLOT_B))
#define Xp (a.out)
#define IN(k) (lo <= (k) && (k) < hi)
#define SEAM(k) do { if ((k) + 1 < hi) xcd_barrier(xbar); } while (0)
#define GEMM_RUN(PERMV, Aptr, Bptr, MM, NN, KK, EE) do { Gemm g_{(Aptr), (Bptr), (MM), (NN), (KK)}; StaticOrder so_; so_.init((MM), (NN), G, bid); gemm_phase<PERMV>(lds, g_, so_, (EE)); } while (0)
#define ROW_RUN(x0, x1, xb, T, gpost, sc, Xo, Xob, gpre, H, n, ab) rowpass(lds, (x0), (x1), (xb), (T), (gpost), (sc), (Xo), (Xob), (gpre), (H), (n), (ab), a.in[13], a.in[15], a.in[16], Gd, BETAp)

    if (IN(0)) {
        for (int jb = 0; jb < 32; ++jb) {
            const float* src = a.in[13]; int K = 1024, ld = 9232, N = 1024, mode = 0, coloff = 0, halfoff = 0; bf16_t* dst = WBp;
            switch (jb) {
            case 0: src = a.in[9]; ld = 5632; N = 5632; mode = 1; halfoff = 2816; dst = WBp + WB_F1A; break;
            case 1: src = a.in[10]; K = 2816; ld = 1024; dst = WBp + WB_F1B; break;
            case 2: N = 3072; dst = WBp + WB_QKV; break;
            case 3: coloff = 3072; dst = WBp + WB_MIX2; break;
            case 4: N = 2048; mode = 1; coloff = 5136; halfoff = 1024; dst = WBp + WB_MIX2 + (size_t)1024 * 1024; break;
            case 5: coloff = 7184; dst = WBp + WB_MIX2 + (size_t)3072 * 1024; break;
            case 6: coloff = 8208; dst = WBp + WB_MIX2 + (size_t)4096 * 1024; break;
            case 7: coloff = 4112; dst = WBp + WB_SB; break;
            case 8: src = a.in[18]; ld = 1024; dst = WBp + WB_GO; break;
            case 9: src = a.in[20]; ld = 1024; dst = WBp + WB_SCO; break;
            case 10: src = a.in[21]; ld = 1024; dst = WBp + WB_MO; break;
            case 11: src = a.in[25]; ld = 1024; dst = WBp + WB_XQ; break;
            case 12: src = a.in[26]; ld = 2048; N = 2048; dst = WBp + WB_XKV; break;
            case 13: src = a.in[27]; ld = 1024; dst = WBp + WB_XO; break;
            case 14: src = a.in[30]; ld = 5632; N = 5632; mode = 1; halfoff = 2816; dst = WBp + WB_F2A; break;
            case 15: src = a.in[31]; K = 2816; ld = 1024; dst = WBp + WB_F2B; break;
            default: { const int sb = jb - 16; src = a.in[4] + (size_t)sb * 262144; K = 256; ld = 1024; dst = VXTp + (size_t)(8 + sb) * 262144; } break;
            }
            cvt_job(lds, src, K, ld, N, mode, coloff, halfoff, dst);
        }
        {
            const float* ck = a.in[3]; bf16_t* dst = KXp + (size_t)8 * 262144;
            for (size_t i = (size_t)bid * 512 + threadIdx.x; i < (size_t)16 * 262144 / 4; i += (size_t)G * 512) { const f32x4 v = __builtin_nontemporal_load((const f32x4*)(ck + i * 4)); u32x2 wv; wv.x = pk2(v[0], v[1]); wv.y = pk2(v[2], v[3]); *(u32x2*)(dst + i * 4) = wv; }
        }
    }
    if (IN(1)) { ROW_RUN(a.in[0], a.in[1], (const bf16_t*)nullptr, (const bf16_t*)nullptr, nullptr, 0.f, (float*)nullptr, (bf16_t*)nullptr, a.in[8], SL(0), M_TOK, false); }
    if (IN(2)) { ROW_RUN(a.in[2], a.in[2], (const bf16_t*)nullptr, (const bf16_t*)nullptr, nullptr, 0.f, (float*)nullptr, (bf16_t*)nullptr, a.in[24], MHp, 2048, false); SEAM(2); }
    if (IN(3)) { EpiArgs E{}; E.mode = M_KV; E.fo0 = a.out + O_MK; E.fo1 = a.out + O_MV; E.o0 = KXp; E.o1 = VXTp; GEMM_RUN(false, MHp, WBp + WB_XKV, 2048, 2048, 1024, E); }
    if (IN(4)) { EpiArgs E{}; E.mode = M_SWIGLU; E.o0 = SL(1); GEMM_RUN(true, SL(0), WBp + WB_F1A, M_TOK, 5632, 1024, E); SEAM(4); }
    if (IN(5)) { EpiArgs E{}; E.mode = M_BF16; E.scale = 1.f; E.o0 = SL(4); GEMM_RUN(true, SL(1), WBp + WB_F1B, M_TOK, 1024, 2816, E); SEAM(5); }
    if (IN(6)) { ROW_RUN(a.in[0], a.in[1], (const bf16_t*)nullptr, (const bf16_t*)SL(4), a.in[11], 0.5f, (float*)nullptr, SL(6), a.in[12], SL(0), M_TOK, true); SEAM(6); }
    if (IN(7)) { EpiArgs E{}; E.mode = M_BF16; E.scale = 1.f; E.o0 = SL(1); GEMM_RUN(true, SL(0), WBp + WB_QKV, M_TOK, 3072, 1024, E); SEAM(7); }
    if (IN(8)) { conv_phase(SL(1), SL(4), SL(5), SL(1), 0, 16, a.in[14], a.in[6], a.out + O_GCP, a.out + O_GCS); SEAM(8); }
    if (IN(9)) { conv_phase(SL(1), SL(4), SL(5), SL(1), 16, 8, a.in[14], a.in[6], a.out + O_GCP, a.out + O_GCS); SEAM(9); }
    if (IN(10)) { chunk_phase(lds, SL(4), SL(5), SL(1), SL(2), SL(3), Gd, BETAp, GCp); SEAM(10); }
    if (IN(11)) { scan_phase(lds, SL(2), SL(4), SL(5), SL(1), SL(3), GCp, a.out  , a.in[5], a.out + O_GSP, a.out + O_GSS); SEAM(11); }
    if (IN(12)) {
        { EpiArgs E{}; E.mode = M_ZOG; E.o0 = SL(2); E.a0 = SL(1); E.f0 = (const float*)a.out; E.f1 = a.in[17]; GEMM_RUN(true, SL(0), WBp + WB_MIX2, M_TOK, 1024, 1024, E); }
        { EpiArgs E{}; E.mode = M_MIX2; E.o0 = SL(3); GEMM_RUN(true, SL(0), WBp + WB_MIX2 + (size_t)1024 * 1024, M_TOK, 2048, 1024, E); }
        { EpiArgs E{}; E.mode = M_BF16; E.scale = 1.f; E.act = 2; E.o0 = SL(4); GEMM_RUN(true, SL(0), WBp + WB_MIX2 + (size_t)3072 * 1024, M_TOK, 2048, 1024, E); }
        SEAM(12); }
    if (IN(13)) {
        for (int idx = bid * 512 + threadIdx.x; idx < 24 * 2048; idx += G * 512) {
            const int seq = idx >> 11, r = (idx >> 10) & 1, cl = idx & 1023;
            const int row = seq < 8 ? seq * 8192 + 8190 + r : NPROMPT + (seq - 8) * 64 + 62 + r;
            float* dst = seq < 8 ? a.out + O_SCP + (size_t)(seq * 2 + r) * 1024 + cl : a.out + O_SCS + (size_t)((seq - 8) * 2 + r) * 1024 + cl;
            *dst = bf2f(SL(3)[(size_t)row * 1024 + cl]);
        }
    }
    if (IN(14)) { EpiArgs E{}; E.mode = M_SB; E.o0 = SL(1); E.a0 = SL(3); E.f0 = a.in[19]; E.f1 = a.in[7]; GEMM_RUN(true, SL(0), WBp + WB_SB, M_TOK, 1024, 1024, E); SEAM(14); }
    if (IN(15)) { EpiArgs E{}; E.mode = M_GDNOUT; E.o0 = SL(4); GEMM_RUN(true, SL(2), WBp + WB_GO, M_TOK, 1024, 1024, E); SEAM(15); }
    if (IN(16)) { EpiArgs E{}; E.mode = M_SCOUT; E.o0 = SL(4); E.a0 = SL(5); GEMM_RUN(true, SL(1), WBp + WB_SCO, M_TOK, 1024, 1024, E); SEAM(16); }
    if (IN(17)) { EpiArgs E{}; E.mode = M_BF16; E.scale = 1.f; E.o0 = SL(2); GEMM_RUN(true, SL(4), WBp + WB_MO, M_TOK, 1024, 1024, E); SEAM(17); }
    if (IN(18)) { ROW_RUN(a.in[0], a.in[1], (const bf16_t*)SL(6), (const bf16_t*)SL(2), a.in[22], 1.0f, (float*)nullptr, SL(6), a.in[23], SL(0), M_TOK, false); SEAM(18); }
    if (IN(19)) { EpiArgs E{}; E.mode = M_BF16; E.scale = 0.0625f; E.o0 = SL(1); GEMM_RUN(true, SL(0), WBp + WB_XQ, M_TOK, 1024, 1024, E); SEAM(19); }
    if (IN(20)) { attn_phase(lds, SL(1), KXp, VXTp, SL(4)); SEAM(20); }
    if (IN(21)) { EpiArgs E{}; E.mode = M_BF16; E.scale = 1.f; E.o0 = SL(2); GEMM_RUN(true, SL(4), WBp + WB_XO, M_TOK, 1024, 1024, E); SEAM(21); }
    if (IN(22)) { ROW_RUN(a.in[0], a.in[1], (const bf16_t*)SL(6), (const bf16_t*)SL(2), a.in[28], 1.0f, (float*)nullptr, SL(6), a.in[29], SL(0), M_TOK, false); SEAM(22); }
    if (IN(23)) { EpiArgs E{}; E.mode = M_SWIGLU; E.o0 = SL(1); GEMM_RUN(true, SL(0), WBp + WB_F2A, M_TOK, 5632, 1024, E); SEAM(23); }
    if (IN(24)) { EpiArgs E{}; E.mode = M_BF16; E.scale = 1.f; E.o0 = SL(4); GEMM_RUN(true, SL(1), WBp + WB_F2B, M_TOK, 1024, 2816, E); SEAM(24); }
    if (IN(25)) { ROW_RUN(a.in[0], a.in[1], (const bf16_t*)SL(6), (const bf16_t*)SL(4), a.in[32], 0.5f, Xp, (bf16_t*)nullptr, (const float*)nullptr, (bf16_t*)nullptr, M_TOK, false); }
}


#ifdef MK_DUMP_OFF
__global__ void dump_kernel(const unsigned* __restrict__ srcw, unsigned* __restrict__ dst, size_t n) {
    for (size_t i = (size_t)blockIdx.x * blockDim.x + threadIdx.x; i < n; i += (size_t)gridDim.x * blockDim.x) { unsigned v = srcw[i]; if ((v & 0x7f800000u) == 0x7f800000u) v &= 0x3fffffffu; dst[i] = v; }
}
#endif
extern "C" void kernel_launch(void* const* d_in, const int* in_sizes, int n_in, void* d_out, int out_size, void* d_ws, size_t ws_size, hipStream_t stream) {
    static int grid = 0;
    if (grid == 0) {
        if (n_in != 33 || ws_size < WS_END) { fprintf(stderr, "kernel_launch: unexpected n_in %d / ws_size %zu (need %zu)\n", n_in, ws_size, (size_t)WS_END); grid = -1; return; }
        int dev = 0, cus = 0, per_cu = 0;
        (void)hipGetDevice(&dev); (void)hipDeviceGetAttribute(&cus, hipDeviceAttributeMultiprocessorCount, dev);
        if (hipFuncSetAttribute((const void*)fwd_kernel, hipFuncAttributeMaxDynamicSharedMemorySize, LDS_BYTES) != hipSuccess) { fprintf(stderr, "kernel_launch: hipFuncSetAttribute failed\n"); grid = -1; return; }
        if (hipOccupancyMaxActiveBlocksPerMultiprocessor(&per_cu, (const void*)fwd_kernel, 512, LDS_BYTES) != hipSuccess || per_cu < 1) { fprintf(stderr, "kernel_launch: occupancy query says %d\n", per_cu); per_cu = 1; }
        (void)hipGetLastError();
        grid = cus * 1;
        if (grid <= 0) grid = 256;
    }
    if (grid < 0) return;
    Args a{};
    for (int i = 0; i < 33; ++i) a.in[i] = (const float*)d_in[i];
    a.out = (float*)d_out; a.ws = (unsigned char*)d_ws;
    (void)hipMemsetAsync((unsigned char*)d_ws + OFF_BAR, 0, 16384, stream);
#if MK_SINGLE
    a.ph_lo = 0; a.ph_hi = (MK_PLIMIT < NPHASE ? MK_PLIMIT : NPHASE);
    void* args[] = {&a};
    hipError_t e = hipLaunchCooperativeKernel((const void*)fwd_kernel, dim3(grid), dim3(512), args, LDS_BYTES, stream);
    if (e != hipSuccess) fprintf(stderr, "cooperative launch failed: %s (grid %d)\n", hipGetErrorString(e), grid);
#else
    for (int p = 0; p < (MK_PLIMIT < NPHASE ? MK_PLIMIT : NPHASE); ++p) {
        a.ph_lo = p; a.ph_hi = p + 1;
        hipLaunchKernelGGL(fwd_kernel, dim3(grid), dim3(512), LDS_BYTES, stream, a);
    }
#endif
#ifdef MK_DUMP_OFF
    hipLaunchKernelGGL(dump_kernel, dim3(2048), dim3(256), 0, stream, (const unsigned*)((const unsigned char*)d_ws + (size_t)(MK_DUMP_OFF)), (unsigned*)d_out, (size_t)(MK_DUMP_N));
#endif
}
```
